# Optimizing an MI355X kernel written in HIP

```python
import jax
import jax.numpy as jnp
from jax import lax
import numpy as np

D_MODEL = 1024
BATCH = 1
SEQ = 16384
DEPTH = 2

HGRN_HEADS = 4
HGRN_DIM = 128
HGRN_WIDTH = HGRN_HEADS * HGRN_DIM
RET_HEADS = 4
RET_DIM = 128
RET_WIDTH = RET_HEADS * RET_DIM
SWA_Q_HEADS = 8
SWA_KV_HEADS = 2
SWA_DIM = 64
SWA_Q_WIDTH = SWA_Q_HEADS * SWA_DIM
SWA_KV_WIDTH = SWA_KV_HEADS * SWA_DIM
WINDOW = 128
SWA_BLOCK = 128
N_BRANCHES = 3
CHUNK = 64
ROPE_THETA = 10000.0
N_MEM = 256
X_HEADS = 4
X_DIM = D_MODEL // X_HEADS
PEER_HEADS = 8
PEER_N_KEYS = 128
PEER_N_EXPERTS = PEER_N_KEYS * PEER_N_KEYS
PEER_TOPK = 16
PEER_QDIM = 256
PEER_HALF = PEER_QDIM // 2
PEER_TOK_BLOCK = 128
EPS = 1e-6
NEG_BIG = -1e30
TINY = 1e-30

IN_SIZES = (HGRN_WIDTH,) * 4 + (RET_WIDTH,) * 4 + (SWA_Q_WIDTH, SWA_KV_WIDTH, SWA_KV_WIDTH, N_BRANCHES * D_MODEL)
IN_COLS = int(sum(IN_SIZES))
IN_SPLITS = tuple(int(c) for c in np.cumsum(IN_SIZES)[:-1])

kernel_name = 'hybrid_hgrn2_retnet_swa_peer'


def rmsnorm(x, g):
    xf = x.astype(jnp.float32)
    y = xf * lax.rsqrt(jnp.mean(xf * xf, axis=-1, keepdims=True) + EPS)
    if g is not None:
        y = y * g.astype(jnp.float32)
    return y.astype(x.dtype)


def rope(a, pos, inv_freq):
    ang = pos.astype(jnp.float32)[:, :, None, None] * inv_freq
    cos, sin = jnp.cos(ang), jnp.sin(ang)
    a1, a2 = jnp.split(a.astype(jnp.float32), 2, axis=-1)
    return jnp.concatenate([a1 * cos - a2 * sin, a2 * cos + a1 * sin], axis=-1).astype(a.dtype)


def split_heads(a, n):
    return a.reshape(a.shape[0], a.shape[1], n, -1)


def bhtd(a):
    return jnp.swapaxes(a, 1, 2)


def to_chunks(a):
    b, h, t, d = a.shape
    return jnp.moveaxis(a.reshape(b, h, t // CHUNK, CHUNK, d), 2, 0)


def from_chunks(a):
    n, b, h, c, d = a.shape
    return jnp.moveaxis(a, 0, 2).reshape(b, h, n * c, d)


def hgrn2_chunkwise(q, k, v, log_f):
    f32 = jnp.float32
    b, h, t, dk = q.shape
    dv = v.shape[-1]
    causal = jnp.tril(jnp.ones((CHUNK, CHUNK), dtype=bool))[:, :, None]

    def step(state, inp):
        qc, kc, vc, gc = inp
        cum = jnp.cumsum(gc, axis=2)
        o_inter = jnp.einsum('bhtk,bhkv->bhtv', qc * jnp.exp(cum), state)
        rel = jnp.where(causal, cum[:, :, :, None, :] - cum[:, :, None, :, :], NEG_BIG)
        scores = jnp.einsum('bhtk,bhsk,bhtsk->bhts', qc, kc, jnp.exp(rel))
        o = o_inter + jnp.einsum('bhts,bhsv->bhtv', scores, vc)
        last = cum[:, :, -1:, :]
        state = jnp.exp(last[:, :, 0, :, None]) * state + jnp.einsum('bhsk,bhsv->bhkv', kc * jnp.exp(last - cum), vc)
        return state, o

    s0 = jnp.zeros((b, h, dk, dv), f32)
    xs = tuple(to_chunks(a.astype(f32)) for a in (q, k, v, log_f))
    _, o = lax.scan(step, s0, xs)
    return from_chunks(o).astype(q.dtype)


def retention_chunkwise(q, k, v, log_gamma):
    f32 = jnp.float32
    b, h, t, dk = q.shape
    dv = v.shape[-1]
    idx = jnp.arange(CHUNK, dtype=f32)
    rel = idx[:, None] - idx[None, :]
    decay = jnp.exp(jnp.where(rel >= 0, log_gamma[:, None, None] * rel, NEG_BIG))
    q_decay = jnp.exp(log_gamma[:, None] * (idx + 1.0))[:, :, None]
    k_decay = jnp.exp(log_gamma[:, None] * (CHUNK - 1.0 - idx))[:, :, None]
    c_decay = jnp.exp(log_gamma * CHUNK)[:, None, None]

    def step(state, inp):
        qc, kc, vc = inp
        o_inter = jnp.einsum('bhtk,bhkv->bhtv', qc, state) * q_decay
        scores = jnp.einsum('bhtk,bhsk->bhts', qc, kc) * decay
        o = o_inter + jnp.einsum('bhts,bhsv->bhtv', scores, vc)
        state = c_decay * state + jnp.einsum('bhsk,bhsv->bhkv', kc * k_decay, vc)
        return state, o

    s0 = jnp.zeros((b, h, dk, dv), f32)
    xs = tuple(to_chunks(a.astype(f32)) for a in (q, k, v))
    _, o = lax.scan(step, s0, xs)
    return from_chunks(o).astype(q.dtype)


def swa_sink_attention(q, k, v, sinks):
    f32 = jnp.float32
    b, hq, t, dh = q.shape
    hkv = k.shape[1]
    g = hq // hkv
    nb = t // SWA_BLOCK
    qb = q.reshape(b, hkv, g, nb, SWA_BLOCK, dh)

    def band(a):
        ab = a.reshape(b, hkv, nb, SWA_BLOCK, dh)
        prev = jnp.pad(ab, ((0, 0), (0, 0), (1, 0), (0, 0), (0, 0)))[:, :, :-1]
        return jnp.concatenate([prev, ab], axis=3)

    kw, vw = band(k), band(v)
    s = jnp.einsum('bhgnqd,bhnkd->bhgnqk', qb, kw).astype(f32) * (dh ** -0.5)
    qi = jnp.arange(SWA_BLOCK)[:, None] + SWA_BLOCK
    ki = jnp.arange(2 * SWA_BLOCK)[None, :]
    rel = qi - ki
    in_window = (rel >= 0) & (rel < WINDOW)
    has_prev = (jnp.arange(nb) > 0)[:, None, None] | (ki >= SWA_BLOCK)[None]
    s = jnp.where(in_window[None] & has_prev, s, NEG_BIG)
    sink = sinks.astype(f32).reshape(1, hkv, g, 1, 1, 1)
    m = jnp.maximum(jnp.max(s, axis=-1, keepdims=True), sink)
    p = jnp.exp(s - m)
    denom = jnp.sum(p, axis=-1, keepdims=True) + jnp.exp(sink - m)
    o = jnp.einsum('bhgnqk,bhnkd->bhgnqd', p / denom, vw.astype(f32))
    return o.reshape(b, hq, t, dh).astype(q.dtype)


def memory_cross_attention(h, m, wq, wk, wv, wo):
    b, t, d = h.shape
    nm = m.shape[1]
    q = (h @ wq).reshape(b, t, X_HEADS, X_DIM)
    k = (m @ wk).reshape(b, nm, X_HEADS, X_DIM)
    v = (m @ wv).reshape(b, nm, X_HEADS, X_DIM)
    s = jnp.einsum('bthd,bmhd->bhtm', q, k).astype(jnp.float32) * (X_DIM ** -0.5)
    p = jax.nn.softmax(s, axis=-1)
    o = jnp.einsum('bhtm,bmhd->bthd', p, v.astype(jnp.float32)).reshape(b, t, d).astype(h.dtype)
    return o @ wo


def peer_ffn(h, wq, sub_keys, u_tab, v_tab):
    f32 = jnp.float32
    b, t, d = h.shape
    q = (h @ wq).reshape(b, t, PEER_HEADS, 2, PEER_HALF)
    s = jnp.einsum('bthpd,phnd->bthpn', q, sub_keys).astype(f32)
    sv, si = lax.top_k(s, PEER_TOPK)
    cand = (sv[..., 0, :, None] + sv[..., 1, None, :]).reshape(b, t, PEER_HEADS, PEER_TOPK * PEER_TOPK)
    cv, ci = lax.top_k(cand, PEER_TOPK)
    e1 = jnp.take_along_axis(si[..., 0, :], ci // PEER_TOPK, axis=-1)
    e2 = jnp.take_along_axis(si[..., 1, :], ci % PEER_TOPK, axis=-1)
    n_blk = (b * t) // PEER_TOK_BLOCK
    n_sel = PEER_HEADS * PEER_TOPK
    idx = (e1 * PEER_N_KEYS + e2).reshape(n_blk, PEER_TOK_BLOCK, n_sel)
    gate = jax.nn.softmax(cv, axis=-1).reshape(n_blk, PEER_TOK_BLOCK, n_sel)
    hb = h.reshape(n_blk, PEER_TOK_BLOCK, d)

    def block(args):
        hh, ii, gg = args
        act = jax.nn.gelu(jnp.einsum('td,ted->te', hh, u_tab[ii]).astype(f32), approximate=False)
        return jnp.einsum('te,ted->td', gg * act, v_tab[ii].astype(f32)).astype(hh.dtype)

    return lax.map(block, (hb, idx, gate)).reshape(b, t, d)


def setup_inputs(seed: int = 0) -> dict:
    key = jax.random.key(seed)
    ks = jax.random.split(key, 24)
    f32 = jnp.float32
    nrm = lambda k, shape, scale: jax.random.normal(k, shape, f32) * scale
    gain = lambda k, shape: 1.0 + 0.02 * jax.random.normal(k, shape, f32)
    offset = jax.random.randint(ks[2], (BATCH, 1), 0, 4096, dtype=jnp.int32)
    positions = offset + jnp.arange(SEQ, dtype=jnp.int32)[None, :]
    return {
        'x': nrm(ks[0], (BATCH, SEQ, D_MODEL), 1.0),
        'mem': nrm(ks[1], (BATCH, N_MEM, D_MODEL), 1.0),
        'positions': positions,
        'ln_mix': gain(ks[3], (DEPTH, D_MODEL)),
        'w_in': nrm(ks[4], (DEPTH, D_MODEL, IN_COLS), D_MODEL ** -0.5),
        'lb_param': nrm(ks[5], (DEPTH, HGRN_WIDTH), 1.0),
        'hgrn_norm': gain(ks[6], (DEPTH, HGRN_WIDTH)),
        'swa_sinks': nrm(ks[7], (DEPTH, SWA_Q_HEADS), 0.5),
        'w_br_hgrn': nrm(ks[8], (DEPTH, HGRN_WIDTH, D_MODEL), HGRN_WIDTH ** -0.5),
        'w_br_ret': nrm(ks[9], (DEPTH, RET_WIDTH, D_MODEL), RET_WIDTH ** -0.5),
        'w_br_swa': nrm(ks[10], (DEPTH, SWA_Q_WIDTH, D_MODEL), SWA_Q_WIDTH ** -0.5),
        'w_out': nrm(ks[11], (DEPTH, D_MODEL, D_MODEL), D_MODEL ** -0.5),
        'ln_xq': gain(ks[12], (DEPTH, D_MODEL)),
        'ln_xkv': gain(ks[13], (DEPTH, D_MODEL)),
        'w_xq': nrm(ks[14], (DEPTH, D_MODEL, D_MODEL), D_MODEL ** -0.5),
        'w_xk': nrm(ks[15], (DEPTH, D_MODEL, D_MODEL), D_MODEL ** -0.5),
        'w_xv': nrm(ks[16], (DEPTH, D_MODEL, D_MODEL), D_MODEL ** -0.5),
        'w_xo': nrm(ks[17], (DEPTH, D_MODEL, D_MODEL), D_MODEL ** -0.5),
        'ln_ffn': gain(ks[18], (DEPTH, D_MODEL)),
        'peer_wq': nrm(ks[19], (DEPTH, D_MODEL, PEER_HEADS * PEER_QDIM), D_MODEL ** -0.5),
        'peer_keys': nrm(ks[20], (DEPTH, 2, PEER_HEADS, PEER_N_KEYS, PEER_HALF), PEER_HALF ** -0.5),
        'peer_u': nrm(ks[21], (DEPTH, PEER_N_EXPERTS, D_MODEL), D_MODEL ** -0.5),
        'peer_v': nrm(ks[22], (DEPTH, PEER_N_EXPERTS, D_MODEL), PEER_HEADS ** -0.5),
        'ln_final': gain(ks[23], (D_MODEL,)),
    }


def reference(x, mem, positions, ln_mix, w_in, lb_param, hgrn_norm, swa_sinks, w_br_hgrn, w_br_ret, w_br_swa, w_out, ln_xq, ln_xkv, w_xq, w_xk, w_xv, w_xo, ln_ffn, peer_wq, peer_keys, peer_u, peer_v, ln_final):
    f32 = jnp.float32
    b, t, d = x.shape
    swa_inv_freq = ROPE_THETA ** (-jnp.arange(0, SWA_DIM, 2, dtype=f32) / SWA_DIM)
    ret_inv_freq = ROPE_THETA ** (-jnp.linspace(0.0, 1.0, RET_DIM // 2, dtype=f32))
    log_gamma = jnp.log(1.0 - 2.0 ** (-5.0 - jnp.arange(RET_HEADS, dtype=f32)))
    lb_sm = jax.nn.softmax(lb_param.astype(f32), axis=0)
    lower = jnp.cumsum(lb_sm, axis=0) - lb_sm[0]

    for l in range(DEPTH):
        h = rmsnorm(x, ln_mix[l])
        (hq, hf, hi, hg, rq, rk, rv, rg, sq, sk, sv, gate_logits) = jnp.split(h @ w_in[l], IN_SPLITS, axis=-1)

        lb = lower[l]
        z = hf.astype(f32)
        f_gate = lb + (1.0 - lb) * jax.nn.sigmoid(z)
        log_f = jnp.log(jnp.maximum(f_gate, TINY))
        k_in = (1.0 - lb) * jax.nn.sigmoid(-z)
        qa = bhtd(split_heads(jax.nn.silu(hq), HGRN_HEADS)) * (HGRN_DIM ** -0.5)
        oa = hgrn2_chunkwise(qa, bhtd(split_heads(k_in, HGRN_HEADS)), bhtd(split_heads(hi, HGRN_HEADS)), bhtd(split_heads(log_f, HGRN_HEADS)))
        oa = rmsnorm(bhtd(oa).reshape(b, t, HGRN_WIDTH), hgrn_norm[l]) * jax.nn.silu(hg)
        y_a = oa @ w_br_hgrn[l]

        qb = bhtd(rope(split_heads(rq, RET_HEADS), positions, ret_inv_freq))
        kb = bhtd(rope(split_heads(rk, RET_HEADS), positions, ret_inv_freq)) * (RET_DIM ** -0.5)
        ob = retention_chunkwise(qb, kb, bhtd(split_heads(rv, RET_HEADS)), log_gamma)
        ob = rmsnorm(bhtd(ob), None).reshape(b, t, RET_WIDTH) * jax.nn.silu(rg)
        y_b = ob @ w_br_ret[l]

        qc = bhtd(rope(split_heads(sq, SWA_Q_HEADS), positions, swa_inv_freq))
        kc = bhtd(rope(split_heads(sk, SWA_KV_HEADS), positions, swa_inv_freq))
        oc = swa_sink_attention(qc, kc, bhtd(split_heads(sv, SWA_KV_HEADS)), swa_sinks[l])
        y_c = bhtd(oc).reshape(b, t, SWA_Q_WIDTH) @ w_br_swa[l]

        gates = jax.nn.sigmoid(gate_logits.reshape(b, t, N_BRANCHES, d))
        mixed = gates[:, :, 0] * y_a + gates[:, :, 1] * y_b + gates[:, :, 2] * y_c
        x = x + mixed @ w_out[l]

        x = x + memory_cross_attention(rmsnorm(x, ln_xq[l]), rmsnorm(mem, ln_xkv[l]), w_xq[l], w_xk[l], w_xv[l], w_xo[l])

        x = x + peer_ffn(rmsnorm(x, ln_ffn[l]), peer_wq[l], peer_keys[l], peer_u[l], peer_v[l])

    return rmsnorm(x, ln_final)
```

```cpp
#ifndef EMU
#include <hip/hip_runtime.h>
#include <hip/hip_cooperative_groups.h>
#include <cstdio>
#include <cstdint>
namespace cg = cooperative_groups;
#endif

#ifndef SEQ_T
#define SEQ_T 16384
#endif
#ifndef N_LAUNCH_MODE
#define N_LAUNCH_MODE 1
#endif
#ifndef DUPMASK
#define DUPMASK 0
#endif
#define DEV __device__ __forceinline__

typedef unsigned short bf16_t;
constexpr int T_ = SEQ_T, D_ = 1024, NIN = 7936, DEPTH = 2, NMEM = 256;
constexpr int NTHREADS = 512;
constexpr int C_HQ = 0, C_HF = 512, C_HI = 1024, C_HG = 1536, C_RQ = 2048, C_RK = 2560, C_RV = 3072, C_RG = 3584, C_SQ = 4096, C_SK = 4608, C_SV = 4736, C_GT = 4864;

DEV float bf2f(bf16_t h) { return __uint_as_float(((unsigned)h) << 16); }
DEV bf16_t f2bf(float f) { unsigned u = __float_as_uint(f); return (bf16_t)((u + 0x7fffu + ((u >> 16) & 1u)) >> 16); }
DEV float sigmoidf_(float x) { return 1.0f / (1.0f + expf(-x)); }
DEV float siluf_(float x) { return x / (1.0f + expf(-x)); }
DEV float geluf_(float x) { return 0.5f * x * (1.0f + erff(x * 0.70710678118654752f)); }


#ifndef PEER_FP4
#define PEER_MFMA 1
#define PEER_FP4 1
#endif
#if PEER_FP4
constexpr float PEER_U_SCALE = 64.0f, PEER_V_SCALE = 5.656854249f;
constexpr int PEER_ROWB = 512;
#else
constexpr float PEER_U_SCALE = 32.0f, PEER_V_SCALE = 4.0f;
constexpr int PEER_ROWB = 1024;
#endif
#ifdef EMU
DEV unsigned char f2fp8_sw(float f) { const unsigned s = (f < 0.f) ? 0x80u : 0u; float a = fabsf(f); if (!(a == a)) return 0x7f; if (a >= 448.f) return (unsigned char)(s | 0x7e);
    if (a < 0.0009765625f) return (unsigned char)s; int e = (int)floorf(log2f(a)); if (e < -6) { const int q = (int)rintf(a * 512.0f); return (unsigned char)(s | (unsigned)q); }
    float m = a / exp2f((float)e); int q = (int)rintf((m - 1.0f) * 8.0f); if (q == 8) { q = 0; ++e; } unsigned code = ((unsigned)(e + 7) << 3) | (unsigned)q; if (code > 0x7e) code = 0x7e; return (unsigned char)(s | code); }
DEV float fp82f_sw(unsigned char c);
DEV unsigned char f2fp4_sw(float f) { const float g[8] = {0.f, 0.5f, 1.f, 1.5f, 2.f, 3.f, 4.f, 6.f}; const float a = fabsf(f); int best = 0; float bd = 1e30f;
    for (int i = 0; i < 8; ++i) { const float d = fabsf(a - g[i]); if (d < bd || (d == bd && (i & 1) == 0)) { bd = d; best = i; } } return (unsigned char)(best | (f < 0.f ? 8 : 0)); }
DEV float fp42f_sw(unsigned char c) { const float g[8] = {0.f, 0.5f, 1.f, 1.5f, 2.f, 3.f, 4.f, 6.f}; return (c & 8) ? -g[c & 7] : g[c & 7]; }
DEV float tab_get_sw(const unsigned char* row, int d) {
#if PEER_FP4
    return fp42f_sw((unsigned char)((row[d >> 1] >> ((d & 1) * 4)) & 15));
#else
    return fp82f_sw(row[d]);
#endif
}
DEV float fp82f_sw(unsigned char c) { const float sg = (c & 0x80) ? -1.f : 1.f; const int e = (c >> 3) & 15, m = c & 7; return sg * (e == 0 ? (float)m * 0.001953125f : (1.0f + (float)m * 0.125f) * exp2f((float)(e - 7))); }
#endif
constexpr size_t MiB = 1u << 20;
constexpr size_t WS_CTL = 0;
constexpr size_t WS_SS = 500 * MiB;
constexpr size_t WS_LB = 512 * 1024;
constexpr size_t WS_WT_IN = 1 * MiB;
constexpr size_t WS_WT_BR = 17 * MiB;
constexpr size_t WS_WT_OUT = 20 * MiB, WS_WT_XQ = 22 * MiB, WS_WT_XK = 24 * MiB, WS_WT_XV = 26 * MiB, WS_WT_XO = 28 * MiB;
constexpr size_t WS_WT_EFF = 30 * MiB;
constexpr size_t WS_HM = 34 * MiB, WS_KX = 34 * MiB + 512 * 1024, WS_VX = 35 * MiB;
constexpr size_t WS_TABU = 348 * MiB, WS_TABV = 364 * MiB;
constexpr size_t WS_ORAW = 36 * MiB;
constexpr size_t WS_TMPMIX = 36 * MiB;
constexpr size_t WS_P = 100 * MiB;
constexpr size_t WS_LOGF = 348 * MiB;
constexpr size_t WS_OBUF = 380 * MiB;
constexpr size_t WS_HB = 428 * MiB;
constexpr size_t WS_MIXB = 460 * MiB;
constexpr size_t WS_QX = 100 * MiB, WS_OX = 132 * MiB;
constexpr size_t WS_XSC = 164 * MiB;
constexpr size_t WS_PSC = 100 * MiB;
constexpr size_t WS_PX = 228 * MiB;
constexpr size_t WS_PIDX = 228 * MiB, WS_PGATE = 236 * MiB, WS_COEF = 244 * MiB;
constexpr size_t WS_KT = 428 * MiB;
constexpr size_t WS_VT = 460 * MiB;
constexpr size_t WS_LS = 36 * MiB;
constexpr size_t WS_ORAWB = 428 * MiB;
constexpr size_t WS_VEC = 492 * MiB;
constexpr size_t WS_SVT = 496 * MiB;
constexpr size_t WS_RS = 507 * MiB;
constexpr size_t WS_END = 508 * MiB;

constexpr int PB_COLS = 4096;
DEV size_t PI(int row, int col) { return col < PB_COLS ? ((((size_t)(row >> 6) * 32 + (size_t)(col >> 7)) << 13) + (size_t)((row & 63) << 7) + (size_t)(col & 127)) : ((size_t)T_ * PB_COLS + (size_t)row * (NIN - PB_COLS) + (size_t)(col - PB_COLS)); }
struct Params { const float* in[24]; float* out; unsigned char* ws; int T; int pad; };

struct Ctx { int gtid, gsize, bid, nb, tid; };
#ifndef EMU
DEV int lane_id_fresh() { int l; asm volatile("v_mbcnt_lo_u32_b32 %0, -1, 0\n\tv_mbcnt_hi_u32_b32 %0, -1, %0" : "=v"(l)); return l; }
#endif
DEV Ctx make_ctx(int wave_u = -1) { Ctx c; int tid = threadIdx.x, bid = blockIdx.x;
#ifndef EMU
    if (wave_u >= 0) tid = wave_u * 64 + lane_id_fresh();
    asm volatile("" : "+v"(tid)); asm volatile("" : "+s"(bid));
#endif
    c.tid = tid; c.bid = bid; c.nb = gridDim.x; c.gtid = bid * (int)blockDim.x + tid; c.gsize = gridDim.x * blockDim.x; return c; }

template <int MAPMODE>
DEV void cvt_transpose(const Ctx& c, const float* src, int ldn, int coff, int K, int N, bf16_t* dst, const float* gain = nullptr) {
    const long total = (long)N * K;
    for (long i = c.gtid; i < total; i += c.gsize) {
        const int n = (int)(i / K), k = (int)(i % K);
        int sn = n;
        if (MAPMODE == 1) { const int hd = n & ~127, j = n & 127; sn = hd + ((j & 1) ? 64 + (j >> 1) : (j >> 1)); }
        if (MAPMODE == 2) { const int hd = n & ~63, j = n & 63; sn = hd + ((j & 1) ? 32 + (j >> 1) : (j >> 1)); }
        dst[i] = f2bf(src[(size_t)k * ldn + coff + sn] * (gain ? gain[k] : 1.0f));
    }
}

DEV void rmsnorm_rows_bf16(const Ctx& c, const float* x, const float* g, bf16_t* dst, int rows);
#ifndef EMU
typedef short bf16x8 __attribute__((ext_vector_type(8)));
typedef float f32x4 __attribute__((ext_vector_type(4)));
typedef unsigned u32x4 __attribute__((ext_vector_type(4)));
extern __shared__ __attribute__((aligned(16))) unsigned char g_lds[];
constexpr int G_BM = 128, G_BN = 128, G_BK = 32, G_LDS_STRIDE = 80;
constexpr int LDS_BYTES = 131072 + 1024;
#endif

template <class E> struct EpiNoBatch { const E& e; DEV void operator()(int, int r, int c, const float* v) const { e(r, c, v); } };
template <class E>
DEV void gemm_bf16_batched(const Ctx& c, const bf16_t* A0, int lda, const bf16_t* Wt0, int M, int N, int K, int nbatch, size_t strideA, size_t strideW, const E& e) {
#ifdef EMU
    for (long w = c.gtid; w < (long)nbatch * M; w += c.gsize) { const int bt = (int)(w / M), m = (int)(w % M); const bf16_t* A = A0 + bt * strideA; const bf16_t* Wt = Wt0 + bt * strideW;
        for (int n = 0; n < N; n += 4) {
            float v[4] = {0.f, 0.f, 0.f, 0.f};
            for (int j = 0; j < 4; ++j) { float s = 0.f; for (int k = 0; k < K; ++k) s += bf2f(A[(size_t)m * lda + k]) * bf2f(Wt[(size_t)(n + j) * K + k]); v[j] = s; }
            e(bt, m, n, v);
        } }
#else
    unsigned char* As = g_lds; unsigned char* Bs = g_lds + 128 * G_LDS_STRIDE;
    const int tid = c.tid, wid = tid >> 6, lane = tid & 63, wm = wid >> 2, wn = wid & 3, fr = lane & 15, fq = lane >> 4;
    const int ntm = M / G_BM, ntn = N / G_BN, ntiles1 = ntm * ntn, ntiles = ntiles1 * nbatch;
    const int lrow = tid >> 2, lkc = tid & 3;
    for (int tile0 = c.bid; tile0 < ntiles; tile0 += c.nb) {
        const int bt = tile0 / ntiles1, tile = tile0 % ntiles1; const bf16_t* A = A0 + bt * strideA; const bf16_t* Wt = Wt0 + bt * strideW;
        const int tm = tile % ntm, tn = tile / ntm, m0 = tm * G_BM, n0 = tn * G_BN;
        f32x4 acc[4][2];
#pragma unroll
        for (int i = 0; i < 4; ++i)
#pragma unroll
            for (int j = 0; j < 2; ++j) acc[i][j] = (f32x4){0.f, 0.f, 0.f, 0.f};
        const bf16_t* ap = A + (size_t)(m0 + lrow) * lda + lkc * 8;
        const bf16_t* bp = Wt + (size_t)(n0 + lrow) * K + lkc * 8;
        for (int k0 = 0; k0 < K; k0 += G_BK) {
            const u32x4 av = *(const u32x4*)(ap + k0), bv = *(const u32x4*)(bp + k0);
            __syncthreads();
            *(u32x4*)(As + lrow * G_LDS_STRIDE + lkc * 16) = av;
            *(u32x4*)(Bs + lrow * G_LDS_STRIDE + lkc * 16) = bv;
            __syncthreads();
            bf16x8 af[4], bfg[2];
#pragma unroll
            for (int i = 0; i < 4; ++i) af[i] = *(const bf16x8*)(As + (wm * 64 + i * 16 + fr) * G_LDS_STRIDE + fq * 16);
#pragma unroll
            for (int j = 0; j < 2; ++j) bfg[j] = *(const bf16x8*)(Bs + (wn * 32 + j * 16 + fr) * G_LDS_STRIDE + fq * 16);
#pragma unroll
            for (int i = 0; i < 4; ++i)
#pragma unroll
                for (int j = 0; j < 2; ++j) acc[i][j] = __builtin_amdgcn_mfma_f32_16x16x32_bf16(bfg[j], af[i], acc[i][j], 0, 0, 0);
        }
#pragma unroll
        for (int i = 0; i < 4; ++i)
#pragma unroll
            for (int j = 0; j < 2; ++j) { float v[4] = {acc[i][j][0], acc[i][j][1], acc[i][j][2], acc[i][j][3]}; e(bt, m0 + wm * 64 + i * 16 + fr, n0 + wn * 32 + j * 16 + 4 * fq, v); }
    }
    __syncthreads();
#endif
}
template <class E>
DEV void gemm_bf16(const Ctx& c, const bf16_t* A, int lda, const bf16_t* Wt, int M, int N, int K, const E& e) { EpiNoBatch<E> eb{e}; gemm_bf16_batched(c, A, lda, Wt, M, N, K, 1, 0, 0, eb); }

#ifndef EMU
namespace pg8 {
#define PG8_LAS __attribute__((address_space(3)))
typedef unsigned short bf16_t;
typedef short bf16x8 __attribute__((ext_vector_type(8)));
typedef float f32x4 __attribute__((ext_vector_type(4)));
typedef unsigned u32x4 __attribute__((ext_vector_type(4)));
constexpr int BM = 256, BK = 64, HALF = 128, HTB = HALF * BK * 2  , STAGE_BYTES = 8 * HTB, NXCD = 8, WGM = 8;

__host__ __device__ __forceinline__ int lds_byte(int r, int c) { const int st = (r >> 4) * 2 + (c >> 5), rr = r & 15, cc = c & 31, ob = rr * 64 + cc * 2; return st * 1024 + (ob ^ (((ob >> 9) & 1) << 5)); }
__host__ __device__ __forceinline__ void stage_rc(int b, int& R, int& C) { const int st = b / 1024, sb = b % 1024, swz = sb ^ (((sb >> 9) & 1) << 5); R = (st >> 1) * 16 + swz / 64; C = (st & 1) * 32 + (swz % 64) / 2; }
__host__ __device__ __forceinline__ int perm32(int rho) { const int n = rho >> 4, i = rho & 15; return 8 * (i >> 2) + 4 * n + (i & 3); }

struct Unit { int pm, pn, z; };
struct Gemm { const bf16_t* A; const bf16_t* Bt; int M, N, K, lda; size_t a_pn_off, a_z_off, b_z_off; };

struct StaticOrder {
    int nM, nN, nwg, G, c;
    __host__ __device__ void init(int M, int N, int G_, int c_) { nM = M / BM; nN = N / BM; nwg = nM * nN; G = G_; c = c_; }
    __host__ __device__ __forceinline__ bool next(int i, Unit& u) const {
        const long L = (long)i * G + c; if (L >= nwg) return false;
        int wgid = (int)L; { const int q = nwg / NXCD, r = nwg % NXCD, xcd = wgid % NXCD, off = wgid / NXCD; wgid = (xcd < r ? xcd * (q + 1) : r * (q + 1) + (xcd - r) * q) + off; }
        const int nig = WGM * nN, gid = wgid / nig, fm = gid * WGM, gsz = (nM - fm) < WGM ? (nM - fm) : WGM;
        u.pm = fm + ((wgid % nig) % gsz); u.pn = (wgid % nig) / gsz; u.z = 0; return true;
    }
    __device__ __forceinline__ void a_ready(const Unit&) const {}
    __device__ __forceinline__ void done(const Unit&) const {}
};


template <class F> struct EpiAdapt { static constexpr bool PERM = false, AFTER_DRAIN = false; F f;
    __device__ __forceinline__ void operator()(const f32x4 (&acc)[2][2][4][2], const Unit& u, int wr, int wc, int fr, int fq) const {
#pragma unroll
        for (int ai = 0; ai < 2; ++ai)
#pragma unroll
            for (int m = 0; m < 4; ++m) { const int row = u.pm * BM + ai * HALF + wr * 64 + m * 16 + fr;
#pragma unroll
                for (int bj = 0; bj < 2; ++bj)
#pragma unroll
                    for (int n = 0; n < 2; ++n) { const int col = u.pn * BM + bj * HALF + wc * 32 + n * 16 + 4 * fq; const f32x4 a = acc[ai][bj][m][n]; float v[4] = {a[0], a[1], a[2], a[3]}; f(row, col, v); } }
    }
};

template <int NZ> struct ZOrder { StaticOrder base;
    __host__ __device__ void init(int M, int N, int G_, int c_) { base.init(M, N, G_, c_); }
    __host__ __device__ __forceinline__ bool next(int i, Unit& u) const { if (!base.next(i / NZ, u)) return false; u.z = i % NZ; return true; }
    __device__ __forceinline__ void a_ready(const Unit&) const {}
    __device__ __forceinline__ void done(const Unit&) const {}
};
struct PlusOrder { StaticOrder base; int NX;
    __host__ __device__ void init(int M, int N, int G_, int c_, int nx) { base.init(M, N, G_, c_); NX = nx; }
    __host__ __device__ __forceinline__ bool next(int i, Unit& u) const { const long L = (long)i * base.G + base.c; if (L < base.nwg) return base.next(i, u); if (L >= base.nwg + NX) return false; u.pm = 0; u.pn = (int)(L - base.nwg); u.z = 1; return true; }
    __device__ __forceinline__ void a_ready(const Unit&) const {}
    __device__ __forceinline__ void done(const Unit&) const {}
};
template <class F> struct EpiAdapt8 { static constexpr bool PERM = true, AFTER_DRAIN = false; F f;
    __device__ __forceinline__ void operator()(const f32x4 (&acc)[2][2][4][2], const Unit& u, int wr, int wc, int fr, int fq) const {
#pragma unroll
        for (int ai = 0; ai < 2; ++ai)
#pragma unroll
            for (int m = 0; m < 4; ++m) { const int row = u.pm * BM + ai * HALF + wr * 64 + m * 16 + fr;
#pragma unroll
                for (int bj = 0; bj < 2; ++bj) { const int col = u.pn * BM + bj * HALF + wc * 32 + 8 * fq; const f32x4 a = acc[ai][bj][m][0], b = acc[ai][bj][m][1];
                    float v[8] = {a[0], a[1], a[2], a[3], b[0], b[1], b[2], b[3]}; f.op8(u.z, row, col, v); } }
    }
};
template <class Epi, class Sched, bool ALIGN_EPI = false, bool SP2 = false>
__device__ __forceinline__ void gemm_phase(PG8_LAS unsigned char* lds, const Gemm g, const Sched& S, const Epi& E, const int tid_in) {
    const int tid = tid_in;
    const int wid = __builtin_amdgcn_readfirstlane(tid >> 6), lane = tid & 63, wr = wid >> 2, wc = wid & 3, fr = lane & 15, fq = lane >> 4;
    const int K = g.K, nt = K / BK;
    unsigned voffA[2], voffB[2];
#pragma unroll
    for (int i = 0; i < 2; ++i) { int R, C; stage_rc(tid * 16 + i * 8192, R, C); const int Rb = Epi::PERM ? ((R & ~31) + perm32(R & 31)) : R;
        voffA[i] = (unsigned)(R * g.lda + C) * 2u; voffB[i] = (unsigned)(Rb * K + C) * 2u; }
    const size_t kstep = (size_t)(BK * 2);
    const size_t hstA = (size_t)HALF * g.lda * 2, hstB = (size_t)HALF * K * 2, tstA = 2 * hstA, tstB = 2 * hstB;
    const unsigned ldsw = (unsigned)wid * 1024u;
    const int aoff = lds_byte(wr * 64 + fr, fq * 8), boff = lds_byte(wc * 32 + fr, fq * 8);
#define PG8_SA(b, h) (((b) * 2 + (h)) * HTB)
#define PG8_SB(b, h) ((4 + (b) * 2 + (h)) * HTB)
#define PG8_STAGE(bufoff, gbase, voff) do { _Pragma("unroll") for (int _i = 0; _i < 2; ++_i) \
        __builtin_amdgcn_global_load_lds((const unsigned*)((const char*)(gbase) + (voff)[_i]), (PG8_LAS unsigned*)(lds + (bufoff) + ldsw + _i * 8192), 16, 0, 0); } while (0)
#define PG8_LDA(dst, b, h) do { _Pragma("unroll") for (int m = 0; m < 4; ++m) _Pragma("unroll") for (int k = 0; k < 2; ++k) dst[m][k] = *(const PG8_LAS bf16x8*)(lds + PG8_SA(b, h) + aoff + m * 2048 + k * 1024); } while (0)
#define PG8_LDB(dst, b, h) do { _Pragma("unroll") for (int n = 0; n < 2; ++n) _Pragma("unroll") for (int k = 0; k < 2; ++k) dst[n][k] = *(const PG8_LAS bf16x8*)(lds + PG8_SB(b, h) + boff + n * 2048 + k * 1024); } while (0)
#define PG8_MMA(ai, bj, At, Bt) do { __builtin_amdgcn_s_setprio(1); _Pragma("unroll") for (int m = 0; m < 4; ++m) _Pragma("unroll") for (int n = 0; n < 2; ++n) _Pragma("unroll") for (int k = 0; k < 2; ++k) \
        acc[ai][bj][m][n] = __builtin_amdgcn_mfma_f32_16x16x32_bf16(Bt[n][k], At[m][k], acc[ai][bj][m][n], 0, 0, 0); __builtin_amdgcn_s_setprio(0); } while (0)
#define PG8_WAIT_V(n) asm volatile("s_waitcnt vmcnt(" #n ")" ::: "memory")
#define PG8_WAIT_L(n) asm volatile("s_waitcnt lgkmcnt(" #n ")" ::: "memory")
#define PG8_BAR __builtin_amdgcn_s_barrier()
#define PG8_SCHED __builtin_amdgcn_sched_barrier(0)
    Unit cur, nxt; int ui = 0;
    if (!S.next(0, cur)) return;
    f32x4 acc[2][2][4][2];
#pragma unroll
    for (int a = 0; a < 2; ++a)
#pragma unroll
        for (int b = 0; b < 2; ++b)
#pragma unroll
            for (int m = 0; m < 4; ++m)
#pragma unroll
                for (int n = 0; n < 2; ++n) acc[a][b][m][n] = (f32x4){0.f, 0.f, 0.f, 0.f};
    bf16x8 At[4][2], B0[2][2], B1[2][2];
    const char* cA = (const char*)g.A + (size_t)cur.pm * tstA + (size_t)cur.pn * g.a_pn_off + (size_t)cur.z * g.a_z_off; const char* cB = (const char*)g.Bt + (size_t)cur.pn * tstB + (size_t)cur.z * g.b_z_off;
    S.a_ready(cur);
    if constexpr (SP2) {
        PG8_STAGE(PG8_SB(0, 0), cB, voffB); PG8_STAGE(PG8_SB(0, 1), cB + hstB, voffB); PG8_STAGE(PG8_SA(0, 0), cA, voffA); PG8_STAGE(PG8_SA(0, 1), cA + hstA, voffA);
        if (wr == 1) PG8_BAR;
        PG8_WAIT_V(2); PG8_BAR;
        PG8_STAGE(PG8_SB(1, 0), cB + kstep, voffB); PG8_STAGE(PG8_SA(1, 0), cA + kstep, voffA); PG8_STAGE(PG8_SB(1, 1), cB + hstB + kstep, voffB);
        PG8_WAIT_V(6); PG8_BAR;
    } else {
        PG8_STAGE(PG8_SB(0, 0), cB, voffB); PG8_STAGE(PG8_SA(0, 0), cA, voffA); PG8_STAGE(PG8_SB(0, 1), cB + hstB, voffB); PG8_STAGE(PG8_SA(0, 1), cA + hstA, voffA);
        if (wr == 1) PG8_BAR;
        PG8_WAIT_V(4); PG8_BAR;
        PG8_STAGE(PG8_SB(1, 0), cB + kstep, voffB); PG8_STAGE(PG8_SA(1, 0), cA + kstep, voffA); PG8_STAGE(PG8_SB(1, 1), cB + hstB + kstep, voffB);
        PG8_WAIT_V(6); PG8_BAR;
    }
    for (;;) {
        const bool has_next = S.next(ui + 1, nxt);
        const char* nA = has_next ? (const char*)g.A + (size_t)nxt.pm * tstA + (size_t)nxt.pn * g.a_pn_off + (size_t)nxt.z * g.a_z_off : cA; const char* nB = has_next ? (const char*)g.Bt + (size_t)nxt.pn * tstB + (size_t)nxt.z * g.b_z_off : cB;
        for (int t = 0; t < nt; t += 2) {
            const bool last = (t == nt - 2);
            const char* a1 = cA + (size_t)(t + 1) * kstep;
            const char* a2 = last ? nA : cA + (size_t)(t + 2) * kstep; const char* b2 = last ? nB : cB + (size_t)(t + 2) * kstep;
            const char* a3 = a2 + kstep; const char* b3 = b2 + kstep;
            if (last && has_next) S.a_ready(nxt);
            if constexpr (SP2) {
            PG8_LDB(B0, 0, 0); PG8_LDB(B1, 0, 1); PG8_SCHED; PG8_LDA(At, 0, 0); PG8_STAGE(PG8_SA(1, 1), a1 + hstA, voffA);
            PG8_WAIT_V(8); PG8_WAIT_L(0); PG8_BAR; PG8_MMA(0, 0, At, B0); PG8_MMA(0, 1, At, B1); PG8_BAR; PG8_SCHED;
            PG8_LDA(At, 0, 1); PG8_STAGE(PG8_SB(0, 0), b2, voffB); PG8_STAGE(PG8_SB(0, 1), b2 + hstB, voffB); PG8_STAGE(PG8_SA(0, 0), a2, voffA);
            PG8_WAIT_V(8); PG8_WAIT_L(0); PG8_BAR; PG8_MMA(1, 0, At, B0); PG8_MMA(1, 1, At, B1); PG8_BAR; PG8_SCHED;
            PG8_LDB(B0, 1, 0); PG8_LDB(B1, 1, 1); PG8_SCHED; PG8_LDA(At, 1, 0); PG8_STAGE(PG8_SA(0, 1), a2 + hstA, voffA);
            PG8_WAIT_V(8); PG8_WAIT_L(0); PG8_BAR; PG8_MMA(0, 0, At, B0); PG8_MMA(0, 1, At, B1); PG8_BAR; PG8_SCHED;
            PG8_LDA(At, 1, 1); PG8_STAGE(PG8_SB(1, 0), b3, voffB); PG8_STAGE(PG8_SB(1, 1), b3 + hstB, voffB); PG8_STAGE(PG8_SA(1, 0), a3, voffA);
            PG8_WAIT_V(8); PG8_WAIT_L(0); PG8_BAR; PG8_MMA(1, 0, At, B0); PG8_MMA(1, 1, At, B1); PG8_BAR; PG8_SCHED;
            } else {
            PG8_LDB(B0, 0, 0); PG8_SCHED; PG8_LDA(At, 0, 0); PG8_STAGE(PG8_SA(1, 1), a1 + hstA, voffA);
            PG8_WAIT_L(8); PG8_BAR; PG8_WAIT_L(0); PG8_MMA(0, 0, At, B0); PG8_BAR; PG8_SCHED;
            PG8_LDB(B1, 0, 1); PG8_STAGE(PG8_SB(0, 0), b2, voffB);
            PG8_BAR; PG8_WAIT_L(0); PG8_MMA(0, 1, At, B1); PG8_BAR;
            PG8_LDA(At, 0, 1); PG8_STAGE(PG8_SA(0, 0), a2, voffA);
            PG8_BAR; PG8_WAIT_L(0); PG8_MMA(1, 0, At, B0); PG8_BAR; PG8_SCHED;
            PG8_STAGE(PG8_SB(0, 1), b2 + hstB, voffB);
            PG8_WAIT_V(6); PG8_BAR; PG8_MMA(1, 1, At, B1); PG8_BAR;
            PG8_LDB(B0, 1, 0); PG8_SCHED; PG8_LDA(At, 1, 0); PG8_STAGE(PG8_SA(0, 1), a2 + hstA, voffA);
            PG8_WAIT_L(8); PG8_BAR; PG8_WAIT_L(0); PG8_MMA(0, 0, At, B0); PG8_BAR; PG8_SCHED;
            PG8_LDB(B1, 1, 1); PG8_STAGE(PG8_SB(1, 0), b3, voffB);
            PG8_BAR; PG8_WAIT_L(0); PG8_MMA(0, 1, At, B1); PG8_BAR;
            PG8_LDA(At, 1, 1); PG8_STAGE(PG8_SA(1, 0), a3, voffA);
            PG8_BAR; PG8_WAIT_L(0); PG8_MMA(1, 0, At, B0); PG8_BAR; PG8_SCHED;
            PG8_STAGE(PG8_SB(1, 1), b3 + hstB, voffB);
            PG8_WAIT_V(6); PG8_BAR; PG8_MMA(1, 1, At, B1); PG8_BAR;
            }
        }
        if constexpr (ALIGN_EPI) { if (wr == 0) PG8_BAR; }
        if constexpr (!Epi::AFTER_DRAIN) { const int lane_e = lane_id_fresh(); const int fr_e = lane_e & 15, fq_e = lane_e >> 4;
            E(acc, cur, wr, wc, fr_e, fq_e); S.done(cur); }
        if (!has_next) break;
#pragma unroll
        for (int a = 0; a < 2; ++a)
#pragma unroll
            for (int b = 0; b < 2; ++b)
#pragma unroll
                for (int m = 0; m < 4; ++m)
#pragma unroll
                    for (int n = 0; n < 2; ++n) acc[a][b][m][n] = (f32x4){0.f, 0.f, 0.f, 0.f};
        cur = nxt; cA = nA; cB = nB; ++ui;
        if constexpr (ALIGN_EPI) { if (wr == 1) PG8_BAR; }
    }
    PG8_WAIT_V(0);
    if constexpr (!ALIGN_EPI) { if (wr == 0) PG8_BAR; }
    PG8_BAR;
    if constexpr (Epi::AFTER_DRAIN) { E.fused(acc, cur, wr, wc, fr, fq, lds, wid, lane); S.done(cur); }
#undef PG8_SA
#undef PG8_SB
#undef PG8_STAGE
#undef PG8_LDA
#undef PG8_LDB
#undef PG8_MMA
#undef PG8_WAIT_V
#undef PG8_WAIT_L
#undef PG8_BAR
#undef PG8_SCHED
}
}

constexpr int PG8_LDS_BYTES = pg8::STAGE_BYTES;
#endif
template <class E>
DEV void gemm_big(const Ctx& c, const bf16_t* A, int lda, const bf16_t* Wt, int M, int N, int K, const E& e) {
#ifdef EMU
    gemm_bf16(c, A, lda, Wt, M, N, K, e);
#else
    pg8::Gemm g{A, Wt, M, N, K, lda, 0, 0, 0}; pg8::StaticOrder S; S.init(M, N, c.nb, c.bid);
    pg8::EpiAdapt8<E> ea{e};
    pg8::gemm_phase<pg8::EpiAdapt8<E>, pg8::StaticOrder, true, true>((PG8_LAS unsigned char*)g_lds, g, S, ea, c.tid);
    __syncthreads();
#endif
}

template <class E>
DEV void gemm_big_r(const Ctx& c, const bf16_t* A, int lda, const bf16_t* Wt, int M, int N, int K, const E& e);
template <class E> struct EpiColOff { const E& e; int off; DEV void operator()(int r, int c, const float* v) const { e(r, c + off, v); } };
template <class E>
DEV void gemm_blockdiag(const Ctx& c, const bf16_t* A, int lda, const bf16_t* Wt, int M, const E& e) {
#ifdef EMU
    for (int h = 0; h < 4; ++h) { EpiColOff<E> eo{e, h * 256}; gemm_bf16(c, A + h * 256, lda, Wt + (size_t)h * 65536, M, 256, 256, eo); }
#else
    pg8::Gemm g{A, Wt, M, 1024, 256, lda, 512, 0, 0}; pg8::StaticOrder S; S.init(M, 1024, c.nb, c.bid);
    pg8::EpiAdapt8<E> ea{e};
    pg8::gemm_phase<pg8::EpiAdapt8<E>, pg8::StaticOrder, true, true>((PG8_LAS unsigned char*)g_lds, g, S, ea, c.tid);
    __syncthreads();
#endif
}
#ifndef EMU
template <int K> DEV float shx(float v) { static_assert(K < 32, "shx: within 32-lane halves"); return __builtin_bit_cast(float, __builtin_amdgcn_ds_swizzle(__builtin_bit_cast(int, v), (K << 10) | 0x1f)); }
DEV float shx32(float v) { return __builtin_bit_cast(float, __builtin_amdgcn_ds_bpermute((lane_id_fresh() ^ 32) << 2, __builtin_bit_cast(int, v))); }
DEV float add32(float v) { return v + shx32(v); }
DEV float max32(float v) { return fmaxf(v, shx32(v)); }
DEV float wave_sum(float v) { v += shx<1>(v); v += shx<2>(v); v += shx<4>(v); v += shx<8>(v); v += shx<16>(v); return add32(v); }
DEV float wave_max(float v) { v = fmaxf(v, shx<1>(v)); v = fmaxf(v, shx<2>(v)); v = fmaxf(v, shx<4>(v)); v = fmaxf(v, shx<8>(v)); v = fmaxf(v, shx<16>(v)); return max32(v); }
DEV int bperm_i(int v, int src_lane) { return __builtin_amdgcn_ds_bpermute(src_lane << 2, v); }
DEV float bperm_f(float v, int src_lane) { return __builtin_bit_cast(float, __builtin_amdgcn_ds_bpermute(src_lane << 2, __builtin_bit_cast(int, v))); }
DEV unsigned pk2bf(float lo, float hi) { unsigned r; asm("v_cvt_pk_bf16_f32 %0, %1, %2" : "=v"(r) : "v"(lo), "v"(hi)); return r; }
typedef __bf16 bf16x2_t __attribute__((ext_vector_type(2)));
DEV float dot2bf(unsigned a, unsigned b, float acc) { return __builtin_amdgcn_fdot2_f32_bf16(__builtin_bit_cast(bf16x2_t, a), __builtin_bit_cast(bf16x2_t, b), acc, false); }
#endif

DEV void rmsnorm_rows_bf16(const Ctx& c, const float* x, const float* g, bf16_t* dst, int rows) {
#ifdef EMU
    for (int r = c.gtid; r < rows; r += c.gsize) {
        const float* xr = x + (size_t)r * D_; float ss = 0.f;
        for (int i = 0; i < D_; ++i) ss += xr[i] * xr[i];
        const float rs = 1.0f / sqrtf(ss * (1.0f / D_) + 1e-6f);
        for (int i = 0; i < D_; ++i) dst[(size_t)r * D_ + i] = f2bf(xr[i] * rs * g[i]);
    }
#else
    const int lane = c.tid & 63, gw = c.gtid >> 6, nw = c.gsize >> 6;
    for (int r = gw; r < rows; r += nw) { const f32x4* xr = (const f32x4*)(x + (size_t)r * D_) + lane; f32x4 v[4]; float ss = 0.f;
#pragma unroll
        for (int j = 0; j < 4; ++j) { v[j] = xr[64 * j]; ss += v[j][0] * v[j][0] + v[j][1] * v[j][1] + v[j][2] * v[j][2] + v[j][3] * v[j][3]; }
        const float rs = 1.0f / sqrtf(wave_sum(ss) * (1.0f / D_) + 1e-6f);
#pragma unroll
        for (int j = 0; j < 4; ++j) { const f32x4 gv = ((const f32x4*)g)[lane + 64 * j]; unsigned* o = (unsigned*)(dst + (size_t)r * D_ + 4 * lane + 256 * j);
            o[0] = pk2bf(v[j][0] * rs * gv[0], v[j][1] * rs * gv[1]); o[1] = pk2bf(v[j][2] * rs * gv[2], v[j][3] * rs * gv[3]); }
    }
#endif
}
DEV void atomic_add_f32(float* p, float v) {
#ifdef EMU
#pragma omp atomic
    *p += v;
#else
    atomicAdd(p, v);
#endif
}
DEV float rstd_from_ss(float ss) { return 1.0f / sqrtf(ss * (1.0f / D_) + 1e-6f); }
constexpr int SSW = 16;
DEV float row_rstd(const float* ssn, int row) {
#ifdef EMU
    return rstd_from_ss(ssn[(size_t)row * SSW]);
#else
    const f32x4* q = (const f32x4*)(ssn + (size_t)row * SSW); const f32x4 a = q[0], b = q[1], c2 = q[2], d = q[3];
    return rstd_from_ss((((a[0] + a[1]) + (a[2] + a[3])) + ((b[0] + b[1]) + (b[2] + b[3]))) + (((c2[0] + c2[1]) + (c2[2] + c2[3])) + ((d[0] + d[1]) + (d[2] + d[3]))));
#endif
}
struct EpiStoreBf16 { bf16_t* O; int ldo; float scale;
    DEV void operator()(int r, int c, const float* v) const { for (int j = 0; j < 4; ++j) O[(size_t)r * ldo + c + j] = f2bf(v[j] * scale); }
#ifndef EMU
    DEV void op8(int, int r, int c, const float* v) const { *(u32x4*)(O + (size_t)r * ldo + c) = (u32x4){pk2bf(v[0] * scale, v[1] * scale), pk2bf(v[2] * scale, v[3] * scale), pk2bf(v[4] * scale, v[5] * scale), pk2bf(v[6] * scale, v[7] * scale)}; }
#endif
};
struct EpiStoreF32 { float* O; int ldo;
    DEV void operator()(int r, int c, const float* v) const { for (int j = 0; j < 4; ++j) O[(size_t)r * ldo + c + j] = v[j]; }
#ifndef EMU
    DEV void op8(int, int r, int c, const float* v) const { f32x4* o = (f32x4*)(O + (size_t)r * ldo + c); o[0] = (f32x4){v[0], v[1], v[2], v[3]}; o[1] = (f32x4){v[4], v[5], v[6], v[7]}; }
#endif
};
struct EpiResidual { bf16_t* xb; float* ss;
    DEV void operator()(int r, int c, const float* v) const { float q = 0.f; for (int j = 0; j < 4; ++j) { const float x = bf2f(f2bf(bf2f(xb[(size_t)r * D_ + c + j]) + v[j])); xb[(size_t)r * D_ + c + j] = f2bf(x); q += x * x; }
        if (ss) atomic_add_f32(ss + (size_t)r * SSW, q); }
};
#ifndef EMU
struct EpiResidualPg8 { static constexpr bool PERM = true, AFTER_DRAIN = false; const bf16_t* src; bf16_t* xb; float* ss;
    __device__ __forceinline__ void operator()(const pg8::f32x4 (&acc)[2][2][4][2], const pg8::Unit& u, int wr, int wc, int fr, int fq) const {
#pragma unroll
        for (int ai = 0; ai < 2; ++ai)
#pragma unroll
            for (int m = 0; m < 4; ++m) { const int row = u.pm * 256 + ai * 128 + wr * 64 + m * 16 + fr; float q = 0.f;
#pragma unroll
                for (int bj = 0; bj < 2; ++bj) { const int col = u.pn * 256 + bj * 128 + wc * 32 + 8 * fq; const size_t o = (size_t)row * D_ + col;
                    const u32x4 xs = *(const u32x4*)(src + o); const f32x4 a0 = acc[ai][bj][m][0], a1 = acc[ai][bj][m][1]; u32x4 w;
                    w[0] = pk2bf(bf2f((bf16_t)(xs[0] & 0xffffu)) + a0[0], __uint_as_float(xs[0] & 0xffff0000u) + a0[1]); w[1] = pk2bf(bf2f((bf16_t)(xs[1] & 0xffffu)) + a0[2], __uint_as_float(xs[1] & 0xffff0000u) + a0[3]);
                    w[2] = pk2bf(bf2f((bf16_t)(xs[2] & 0xffffu)) + a1[0], __uint_as_float(xs[2] & 0xffff0000u) + a1[1]); w[3] = pk2bf(bf2f((bf16_t)(xs[3] & 0xffffu)) + a1[2], __uint_as_float(xs[3] & 0xffff0000u) + a1[3]);
                    *(u32x4*)(xb + o) = w;
#pragma unroll
                    for (int i = 0; i < 4; ++i) { const float lo = bf2f((bf16_t)(w[i] & 0xffffu)), hi = __uint_as_float(w[i] & 0xffff0000u); q += lo * lo + hi * hi; } }
                if (ss) { q += shx<16>(q); q = add32(q); if (fq == 0) ss[(size_t)row * SSW + u.pn * 4 + wc] = q; } }
    }
};
#endif

#ifndef EMU
template <class F> struct EpiAdapt8R { static constexpr bool PERM = true, AFTER_DRAIN = false; F f;
    __device__ __forceinline__ void operator()(const pg8::f32x4 (&acc)[2][2][4][2], const pg8::Unit& u, int wr, int wc, int fr, int fq) const {
        float rsv[2][4];
#pragma unroll
        for (int ai = 0; ai < 2; ++ai)
#pragma unroll
            for (int m = 0; m < 4; ++m) rsv[ai][m] = f.rs[u.pm * 256 + ai * 128 + wr * 64 + m * 16 + fr];
#pragma unroll
        for (int ai = 0; ai < 2; ++ai)
#pragma unroll
            for (int m = 0; m < 4; ++m) { const int row = u.pm * 256 + ai * 128 + wr * 64 + m * 16 + fr;
#pragma unroll
                for (int bj = 0; bj < 2; ++bj) { const int col = u.pn * 256 + bj * 128 + wc * 32 + 8 * fq; const pg8::f32x4 a = acc[ai][bj][m][0], b = acc[ai][bj][m][1];
                    float v[8] = {a[0], a[1], a[2], a[3], b[0], b[1], b[2], b[3]}; f.op8r(row, col, v, rsv[ai][m]); } }
    }
};
#endif
struct EpiRowScaleBf16 { bf16_t* O; int ldo; float scale; const float* ss; const float* rs;
    DEV void operator()(int r, int c, const float* v) const { const float rs = scale * row_rstd(ss, r); for (int j = 0; j < 4; ++j) O[(size_t)r * ldo + c + j] = f2bf(v[j] * rs); }
#ifndef EMU
    DEV void op8r(int r, int c, const float* v, float rs0) const { const float rs = scale * rs0; *(u32x4*)(O + (size_t)r * ldo + c) = (u32x4){pk2bf(v[0] * rs, v[1] * rs), pk2bf(v[2] * rs, v[3] * rs), pk2bf(v[4] * rs, v[5] * rs), pk2bf(v[6] * rs, v[7] * rs)}; }
#endif
};
struct EpiRowScaleF32 { float* O; int ldo; const float* ss; const float* rs;
    DEV void operator()(int r, int c, const float* v) const { const float rs = row_rstd(ss, r); for (int j = 0; j < 4; ++j) O[(size_t)r * ldo + c + j] = v[j] * rs; }
#ifndef EMU
    DEV void op8r(int r, int c, const float* v, float rs) const { bf16_t* o = (bf16_t*)O + ((size_t)((r >> 8) * (ldo >> 8) + (c >> 8)) << 16) + ((size_t)(c & 255) << 8) + (r & 255);
#pragma unroll
        for (int j = 0; j < 8; ++j) o[j * 256] = f2bf(v[j] * rs); }
#endif
};
#ifndef EMU
template <class Sched> DEV void prep_rstd(const Ctx& c, const float* ssn, float* rs, const Sched& S) {
    pg8::Unit u; int last = -1;
    for (int i = 0; S.next(i, u); ++i) { if (u.pm != last && c.tid < 256) rs[u.pm * 256 + c.tid] = row_rstd(ssn, u.pm * 256 + c.tid); last = u.pm; }
    asm volatile("s_waitcnt vmcnt(0)" ::: "memory"); __syncthreads();
}
#endif
template <class E>
DEV void gemm_big_r(const Ctx& c, const bf16_t* A, int lda, const bf16_t* Wt, int M, int N, int K, const E& e) {
#ifdef EMU
    gemm_bf16(c, A, lda, Wt, M, N, K, e);
#else
    pg8::Gemm g{A, Wt, M, N, K, lda, 0, 0, 0}; pg8::StaticOrder S; S.init(M, N, c.nb, c.bid);
    prep_rstd(c, e.ss, const_cast<float*>(e.rs), S);
    EpiAdapt8R<E> ea{e};
    pg8::gemm_phase<EpiAdapt8R<E>, pg8::StaticOrder, true, true>((PG8_LAS unsigned char*)g_lds, g, S, ea, c.tid);
    __syncthreads();
#endif
}

struct EpiBranch { int b; const bf16_t* P; float* tmp; bf16_t* mixb;
    DEV void operator()(int r, int c, const float* v) const {
        for (int j = 0; j < 4; ++j) { const float g = bf2f(P[PI(r, C_GT + b * D_ + c + j)]); const size_t o = (size_t)r * D_ + c + j;
            float t = g * v[j]; if (b > 0) t += tmp[o]; if (b < 2) tmp[o] = t; else mixb[o] = f2bf(t); } } };
#ifndef EMU
struct EpiBranch8 { const bf16_t* P; bf16_t* tmp; bf16_t* mixb;
    DEV void op8(int z, int r, int c, const float* v) const {
        const u32x4 g = *(const u32x4*)(P + PI(r, C_GT + z * D_ + c)); float t[8];
#pragma unroll
        for (int i = 0; i < 4; ++i) { t[2 * i] = bf2f((bf16_t)(g[i] & 0xffffu)) * v[2 * i]; t[2 * i + 1] = __uint_as_float(g[i] & 0xffff0000u) * v[2 * i + 1]; }
        if (z > 0) { const u32x4 o = *(const u32x4*)(tmp + (size_t)r * D_ + c);
#pragma unroll
            for (int i = 0; i < 4; ++i) { t[2 * i] += bf2f((bf16_t)(o[i] & 0xffffu)); t[2 * i + 1] += __uint_as_float(o[i] & 0xffff0000u); } }
        *(u32x4*)((z < 2 ? tmp : mixb) + (size_t)r * D_ + c) = (u32x4){pk2bf(t[0], t[1]), pk2bf(t[2], t[3]), pk2bf(t[4], t[5]), pk2bf(t[6], t[7])};
    } };
#endif
struct EpiInProj { bf16_t* P; float* lgf; const float* lb; const int* pos; const float* ss;
    DEV void operator()(int r, int c, const float* vin) const {
        float o[4], v[4]; { const float rs = row_rstd(ss, r); for (int j = 0; j < 4; ++j) v[j] = vin[j] * rs; }
        if (c < C_HF) { for (int j = 0; j < 4; ++j) o[j] = siluf_(v[j]) * 0.08838834764831845f; }
        else if (c < C_HI) { for (int j = 0; j < 4; ++j) { const float l = lb[c - C_HF + j], z = v[j]; const float f = l + (1.0f - l) * sigmoidf_(z);
                lgf[(size_t)r * 512 + (c - C_HF) + j] = logf_safe(f); o[j] = (1.0f - l) * sigmoidf_(-z); } }
        else if (c < C_HG) { for (int j = 0; j < 4; ++j) o[j] = v[j]; }
        else if (c < C_RQ) { for (int j = 0; j < 4; ++j) o[j] = siluf_(v[j]); }
        else if (c < C_RV) { const float sc = (c >= C_RK) ? 0.08838834764831845f : 1.0f; const float p = (float)pos[r];
            for (int q = 0; q < 2; ++q) { const int i = ((c & 127) >> 1) + q; const float invf = exp2f(-(float)i * (13.287712379549449f / 63.0f)); const float ang = p * invf;
                const float cs = cosf(ang), sn = sinf(ang), a1 = v[2 * q], a2 = v[2 * q + 1]; o[2 * q] = (a1 * cs - a2 * sn) * sc; o[2 * q + 1] = (a2 * cs + a1 * sn) * sc; } }
        else if (c < C_RG) { for (int j = 0; j < 4; ++j) o[j] = v[j]; }
        else if (c < C_SQ) { for (int j = 0; j < 4; ++j) o[j] = siluf_(v[j]); }
        else if (c < C_SV) { const float sc = (c < C_SK) ? 0.125f : 1.0f; const float p = (float)pos[r]; const int cc = (c < C_SK) ? (c - C_SQ) : (c - C_SK);
            for (int q = 0; q < 2; ++q) { const int i = ((cc & 63) >> 1) + q; const float invf = exp2f(-(float)i * (13.287712379549449f / 32.0f)); const float ang = p * invf;
                const float cs = cosf(ang), sn = sinf(ang), a1 = v[2 * q], a2 = v[2 * q + 1]; o[2 * q] = (a1 * cs - a2 * sn) * sc; o[2 * q + 1] = (a2 * cs + a1 * sn) * sc; } }
        else if (c < C_GT) { for (int j = 0; j < 4; ++j) o[j] = v[j]; }
        else { for (int j = 0; j < 4; ++j) o[j] = sigmoidf_(v[j]); }
        for (int j = 0; j < 4; ++j) P[PI(r, c + j)] = f2bf(o[j]);
    }
    static DEV float logf_safe(float f) { return logf(fmaxf(f, 1e-30f)); }
};


#ifndef EMU
struct EpiInProjPg8 { static constexpr bool PERM = true, AFTER_DRAIN = false; bf16_t* P; float* lgf; const float* lb; const int* pos; const float* rs; bf16_t* kxh; bf16_t* vxt;
    __device__ __forceinline__ void operator()(const pg8::f32x4 (&acc)[2][2][4][2], const pg8::Unit& u, int wr, int wc, int fr, int fq) const {
        if (u.z == 1) {
#pragma unroll
            for (int ai = 0; ai < 2; ++ai)
#pragma unroll
                for (int m = 0; m < 4; ++m) { const int row = ai * 128 + wr * 64 + m * 16 + fr;
#pragma unroll
                    for (int bj = 0; bj < 2; ++bj) { const int col = u.pn * 256 + bj * 128 + wc * 32 + 8 * fq; const pg8::f32x4 a = acc[ai][bj][m][0], b = acc[ai][bj][m][1];
                        if (col < 1024) { const int h = col >> 8, d = col & 255; *(u32x4*)(kxh + ((size_t)h * 256 + row) * 256 + d) = (u32x4){pk2bf(a[0], a[1]), pk2bf(a[2], a[3]), pk2bf(b[0], b[1]), pk2bf(b[2], b[3])}; }
                        else { const int cc = col - 1024, h = cc >> 8, d = cc & 255; const float v8[8] = {a[0], a[1], a[2], a[3], b[0], b[1], b[2], b[3]};
#pragma unroll
                            for (int j = 0; j < 8; ++j) vxt[((size_t)h * 256 + d + j) * 256 + row] = f2bf(v8[j]); } } }
            return; }
        int cl = wc * 32 + 8 * fq;
        asm volatile("" : "+v"(cl));
        float invr[4], invs[4], rsv[2][4];
#pragma unroll
        for (int ai = 0; ai < 2; ++ai)
#pragma unroll
            for (int m = 0; m < 4; ++m) rsv[ai][m] = rs[u.pm * 256 + ai * 128 + wr * 64 + m * 16 + fr];
#pragma unroll
        for (int q = 0; q < 4; ++q) { invr[q] = exp2f(-(float)((cl >> 1) + q) * (13.287712379549449f / 63.0f)); invs[q] = exp2f(-(float)(((cl & 63) >> 1) + q) * (13.287712379549449f / 32.0f)); }
#pragma unroll
        for (int bj = 0; bj < 2; ++bj) {
            const int cb = u.pn * 256 + bj * 128, c0 = cb + cl;
            int ty; float sc = 1.0f;
            if (cb < C_HF) { ty = 0; sc = 0.08838834764831845f; } else if (cb < C_HI) ty = 1; else if (cb < C_HG) ty = 2; else if (cb < C_RQ) ty = 0;
            else if (cb < C_RV) { ty = 3; sc = (cb >= C_RK) ? 0.08838834764831845f : 1.0f; } else if (cb < C_RG) ty = 2; else if (cb < C_SQ) ty = 0;
            else if (cb < C_SV) { ty = 4; sc = (cb < C_SK) ? 0.125f : 1.0f; } else if (cb < C_GT) ty = 2; else ty = 5;
            float lbv[8];
            if (ty == 1) {
#pragma unroll
                for (int j = 0; j < 8; ++j) lbv[j] = lb[c0 - C_HF + j]; }
#pragma unroll
            for (int ai = 0; ai < 2; ++ai)
#pragma unroll
                for (int m = 0; m < 4; ++m) {
                    const int row = u.pm * 256 + ai * 128 + wr * 64 + m * 16 + fr;
                    float v[8], o[8]; const float rs = rsv[ai][m];
#pragma unroll
                    for (int j = 0; j < 8; ++j) v[j] = acc[ai][bj][m][j >> 2][j & 3] * rs;
                    if (ty == 0) {
#pragma unroll
                        for (int j = 0; j < 8; ++j) o[j] = v[j] * sc * __builtin_amdgcn_rcpf(1.0f + __expf(-v[j])); }
                    else if (ty == 1) { float lf[8];
#pragma unroll
                        for (int j = 0; j < 8; ++j) { const float sg = __builtin_amdgcn_rcpf(1.0f + __expf(-v[j])); const float f = lbv[j] + (1.0f - lbv[j]) * sg; lf[j] = __logf(fmaxf(f, 1e-30f)); o[j] = (1.0f - lbv[j]) * (1.0f - sg); }
                        float* lp = lgf + (size_t)row * 512 + (c0 - C_HF); *(pg8::f32x4*)lp = (pg8::f32x4){lf[0], lf[1], lf[2], lf[3]}; *(pg8::f32x4*)(lp + 4) = (pg8::f32x4){lf[4], lf[5], lf[6], lf[7]}; }
                    else if (ty == 2) {
#pragma unroll
                        for (int j = 0; j < 8; ++j) o[j] = v[j]; }
                    else if (ty == 3 || ty == 4) { const float pf = (float)pos[row];
#pragma unroll
                        for (int q = 0; q < 4; ++q) { const float ang = pf * (ty == 3 ? invr[q] : invs[q]); float rev = ang * 0.15915494309189535f; rev = rev - floorf(rev);
                            const float sn = __builtin_amdgcn_sinf(rev), cs = __builtin_amdgcn_cosf(rev), a1 = v[2 * q], a2 = v[2 * q + 1]; o[2 * q] = (a1 * cs - a2 * sn) * sc; o[2 * q + 1] = (a2 * cs + a1 * sn) * sc; } }
                    else {
#pragma unroll
                        for (int j = 0; j < 8; ++j) o[j] = __builtin_amdgcn_rcpf(1.0f + __expf(-v[j])); }
                    pg8::u32x4 w; w.x = pk2bf(o[0], o[1]); w.y = pk2bf(o[2], o[3]);
                    w.z = pk2bf(o[4], o[5]); w.w = pk2bf(o[6], o[7]);
                    *(pg8::u32x4*)(P + PI(row, c0)) = w;
                }
        }
    }
};
#endif
#ifndef EMU
struct EpiSoftmaxPg8 { static constexpr bool PERM = true, AFTER_DRAIN = true; bf16_t* PX;
    __device__ __forceinline__ void fused(pg8::f32x4 (&acc)[2][2][4][2], const pg8::Unit& u, int wr, int wc, int fr, int fq, PG8_LAS unsigned char* lds, int wid, int lane) const {
        PG8_LAS float* pm = (PG8_LAS float*)lds;
        PG8_LAS float* ps = (PG8_LAS float*)(lds + 4096);
        float mx[2][4];
#pragma unroll
        for (int ai = 0; ai < 2; ++ai)
#pragma unroll
            for (int m = 0; m < 4; ++m) { float v = -3.0e38f;
#pragma unroll
                for (int bj = 0; bj < 2; ++bj)
#pragma unroll
                    for (int n = 0; n < 2; ++n) { const pg8::f32x4 a = acc[ai][bj][m][n]; v = fmaxf(v, fmaxf(fmaxf(a[0], a[1]), fmaxf(a[2], a[3]))); }
                v = fmaxf(v, shx<16>(v)); v = max32(v); mx[ai][m] = v;
                if (fq == 0) pm[(ai * 128 + wr * 64 + m * 16 + fr) * 4 + wc] = v; }
        __syncthreads();
        float sm[2][4];
#pragma unroll
        for (int ai = 0; ai < 2; ++ai)
#pragma unroll
            for (int m = 0; m < 4; ++m) { const int r = ai * 128 + wr * 64 + m * 16 + fr; const float gm = fmaxf(fmaxf(pm[r * 4 + 0], pm[r * 4 + 1]), fmaxf(pm[r * 4 + 2], pm[r * 4 + 3])); float sacc = 0.f;
#pragma unroll
                for (int bj = 0; bj < 2; ++bj)
#pragma unroll
                    for (int n = 0; n < 2; ++n) { pg8::f32x4 a = acc[ai][bj][m][n]; a[0] = __expf(a[0] - gm); a[1] = __expf(a[1] - gm); a[2] = __expf(a[2] - gm); a[3] = __expf(a[3] - gm); acc[ai][bj][m][n] = a; sacc += (a[0] + a[1]) + (a[2] + a[3]); }
                sacc += shx<16>(sacc); sacc = add32(sacc); sm[ai][m] = sacc;
                if (fq == 0) ps[r * 4 + wc] = sacc; }
        __syncthreads();
#pragma unroll
        for (int ai = 0; ai < 2; ++ai)
#pragma unroll
            for (int m = 0; m < 4; ++m) { const int r = ai * 128 + wr * 64 + m * 16 + fr; const float inv = __builtin_amdgcn_rcpf((ps[r * 4 + 0] + ps[r * 4 + 1]) + (ps[r * 4 + 2] + ps[r * 4 + 3]));
#pragma unroll
                for (int bj = 0; bj < 2; ++bj) { const pg8::f32x4 a = acc[ai][bj][m][0] * inv, b = acc[ai][bj][m][1] * inv;
                    *(u32x4*)(PX + (size_t)(u.pm * 256 + r) * D_ + u.pn * 256 + bj * 128 + wc * 32 + 8 * fq) = (u32x4){pk2bf(a[0], a[1]), pk2bf(a[2], a[3]), pk2bf(b[0], b[1]), pk2bf(b[2], b[3])}; } }
        (void)mx; (void)sm; (void)wid; (void)lane;
    }
};
#endif
struct EpiKXh { bf16_t* O;
    DEV void operator()(int r, int c, const float* v) const { const int h = c >> 8, d = c & 255; for (int j = 0; j < 4; ++j) O[((size_t)h * 256 + r) * 256 + d + j] = f2bf(v[j]); } };
struct EpiVXT { bf16_t* O;
    DEV void operator()(int r, int c, const float* v) const { const int h = c >> 8, d = c & 255; for (int j = 0; j < 4; ++j) O[((size_t)h * 256 + d + j) * 256 + r] = f2bf(v[j]); } };
struct EpiLS { bf16_t* LS; const float* VEC;
    DEV void operator()(int bt, int r, int cc, const float* v) const { for (int j = 0; j < 4; ++j) LS[((size_t)bt * 128 + r) * 128 + cc + j] = f2bf(v[j] * VEC[(size_t)bt * 384 + 256 + cc + j]); } };

DEV unsigned fkey(float x) { unsigned u = __float_as_uint(x); return (u & 0x80000000u) ? ~u : (u | 0x80000000u); }
DEV float fkey_inv(unsigned k) { return __uint_as_float((k & 0x80000000u) ? (k & 0x7fffffffu) : ~k); }
DEV void ce_desc(unsigned& a, unsigned& b) { const unsigned hi = a > b ? a : b, lo = a > b ? b : a; a = hi; b = lo; }
DEV void bitonic_sort16_desc(unsigned (&a)[16]) {
#pragma unroll
    for (int k = 2; k <= 16; k <<= 1)
#pragma unroll
        for (int j = k >> 1; j > 0; j >>= 1)
#pragma unroll
            for (int i = 0; i < 16; ++i) { const int l = i ^ j; if (l > i) { if ((i & k) == 0) ce_desc(a[i], a[l]); else ce_desc(a[l], a[i]); } }
}
DEV void merge_top16(unsigned (&t)[16], const unsigned (&g)[16]) {
#pragma unroll
    for (int i = 0; i < 16; ++i) t[i] = t[i] > g[15 - i] ? t[i] : g[15 - i];
#pragma unroll
    for (int j = 8; j > 0; j >>= 1)
#pragma unroll
        for (int i = 0; i < 16; ++i) { const int l = i ^ j; if (l > i) ce_desc(t[i], t[l]); }
}
constexpr int cand_pos(int a, int b) { int n = 0; for (int x = 0; x < 16; ++x) for (int y = 0; y < 16; ++y) { if (x == a && y == b) return n; if ((x + 1) * (y + 1) <= 16) ++n; } return n; }
static_assert(cand_pos(15, 0) == 49, "50 candidate pairs");
template <int A, int B> struct CandPos { static constexpr int v = cand_pos(A, B); };
template <int A, int B> DEV void cand_fill_b(unsigned (&ck)[64], const float (&v0)[16], const float (&v1)[16]) {
    if constexpr ((A + 1) * (B + 1) <= 16) { ck[CandPos<A, B>::v] = (fkey(v0[A] + v1[B]) & ~255u) | (unsigned)(A * 16 + B); }
    if constexpr (B + 1 < 16) cand_fill_b<A, B + 1>(ck, v0, v1);
}
template <int A> DEV void cand_fill_a(unsigned (&ck)[64], const float (&v0)[16], const float (&v1)[16]) { cand_fill_b<A, 0>(ck, v0, v1); if constexpr (A + 1 < 16) cand_fill_a<A + 1>(ck, v0, v1); }
struct Lay {
    const float *ln_mix, *w_in, *lb_param, *hgrn_norm, *sinks, *w_br[3], *w_out, *ln_xq, *ln_xkv, *w_xq, *w_xk, *w_xv, *w_xo, *ln_ffn, *peer_wq, *peer_keys, *peer_u, *peer_v;
};
DEV Lay make_lay(const Params& p, int l) {
    Lay L; L.ln_mix = p.in[3] + (size_t)l * D_; L.w_in = p.in[4] + (size_t)l * D_ * NIN; L.lb_param = p.in[5]; L.hgrn_norm = p.in[6] + (size_t)l * 512; L.sinks = p.in[7] + l * 8;
    L.w_br[0] = p.in[8] + (size_t)l * 512 * D_; L.w_br[1] = p.in[9] + (size_t)l * 512 * D_; L.w_br[2] = p.in[10] + (size_t)l * 512 * D_;
    L.w_out = p.in[11] + (size_t)l * D_ * D_; L.ln_xq = p.in[12] + (size_t)l * D_; L.ln_xkv = p.in[13] + (size_t)l * D_;
    L.w_xq = p.in[14] + (size_t)l * D_ * D_; L.w_xk = p.in[15] + (size_t)l * D_ * D_; L.w_xv = p.in[16] + (size_t)l * D_ * D_; L.w_xo = p.in[17] + (size_t)l * D_ * D_;
    L.ln_ffn = p.in[18] + (size_t)l * D_; L.peer_wq = p.in[19] + (size_t)l * D_ * 2048; L.peer_keys = p.in[20] + (size_t)l * 2 * 8 * 128 * 128;
    L.peer_u = p.in[21] + (size_t)l * 16384 * D_; L.peer_v = p.in[22] + (size_t)l * 16384 * D_; return L;
}
#define WSP(type, off) ((type*)(p.ws + (off)))

constexpr int N_STAGES_PER_LAYER = 20;
constexpr int N_STAGES = DEPTH * N_STAGES_PER_LAYER + 1;

DEV void run_final(const Params& p) {
    const Ctx c = make_ctx(); const int T = p.T;
    const float* g = p.in[23];
#ifdef EMU
    for (int r = c.gtid; r < T; r += c.gsize) { float* xr = p.out + (size_t)r * D_; float ss = 0.f; for (int i = 0; i < D_; ++i) ss += xr[i] * xr[i];
        const float rs = 1.0f / sqrtf(ss * (1.0f / D_) + 1e-6f); for (int i = 0; i < D_; ++i) xr[i] = xr[i] * rs * g[i]; }
#else
    const int lane = c.tid & 63, gw = c.gtid >> 6, nw = c.gsize >> 6;
    for (int r = gw; r < T; r += nw) { f32x4* xr = (f32x4*)(p.out + (size_t)r * D_) + lane; f32x4 v[4]; float ss = 0.f;
#pragma unroll
        for (int j = 0; j < 4; ++j) { v[j] = xr[64 * j]; ss += v[j][0] * v[j][0] + v[j][1] * v[j][1] + v[j][2] * v[j][2] + v[j][3] * v[j][3]; }
        const float rs = 1.0f / sqrtf(wave_sum(ss) * (1.0f / D_) + 1e-6f);
#pragma unroll
        for (int j = 0; j < 4; ++j) { const f32x4 gv = ((const f32x4*)g)[lane + 64 * j]; xr[64 * j] = (f32x4){v[j][0] * rs * gv[0], v[j][1] * rs * gv[1], v[j][2] * rs * gv[2], v[j][3] * rs * gv[3]}; }
    }
#endif
}
DEV void run_stage_ls(const Params& p, const int l_in, const int s, const bool dry = false, const int wave_u = -1) {
    int l = l_in;
#ifndef EMU
    asm volatile("" : "+s"(l));
#endif
    const Ctx c = make_ctx(wave_u);
    const int T = p.T;
#ifdef ONLY_STAGE
    if (s != ONLY_STAGE) return;
#endif
    const Lay L = make_lay(p, l);
    const float* xsrc = (l == 0) ? p.in[0] : p.out;
    const int* pos = (const int*)p.in[2];
    bf16_t* P = WSP(bf16_t, WS_P); bf16_t* HB = WSP(bf16_t, WS_HB); bf16_t* OBUF = WSP(bf16_t, WS_OBUF);
    float* SS = WSP(float, WS_SS);
    switch (s) {
    case 0: {
        bf16_t* wt = WSP(bf16_t, WS_WT_IN);
#ifdef EMU
        cvt_transpose<0>(c, L.w_in, NIN, 0, D_, 2048, wt, L.ln_mix);
        cvt_transpose<1>(c, L.w_in, NIN, C_RQ, D_, 1024, wt + (size_t)C_RQ * D_, L.ln_mix);
        cvt_transpose<0>(c, L.w_in, NIN, C_RV, D_, 1024, wt + (size_t)C_RV * D_, L.ln_mix);
        cvt_transpose<2>(c, L.w_in, NIN, C_SQ, D_, 640, wt + (size_t)C_SQ * D_, L.ln_mix);
        cvt_transpose<0>(c, L.w_in, NIN, C_SV, D_, NIN - C_SV, wt + (size_t)C_SV * D_, L.ln_mix);
        for (int b = 0; b < 3; ++b) cvt_transpose<0>(c, L.w_br[b], D_, 0, 512, D_, WSP(bf16_t, WS_WT_BR) + (size_t)b * D_ * 512);
        cvt_transpose<0>(c, L.w_out, D_, 0, D_, D_, WSP(bf16_t, WS_WT_OUT));
        cvt_transpose<0>(c, L.w_xq, D_, 0, D_, D_, WSP(bf16_t, WS_WT_XQ), L.ln_xq);
        cvt_transpose<0>(c, L.w_xk, D_, 0, D_, D_, WSP(bf16_t, WS_WT_XK));
        cvt_transpose<0>(c, L.w_xv, D_, 0, D_, D_, WSP(bf16_t, WS_WT_XV));
        cvt_transpose<0>(c, L.w_xo, D_, 0, D_, D_, WSP(bf16_t, WS_WT_XO));
#else
        {
            float* Ls = (float*)g_lds; const int tid = c.tid;
            constexpr int NT_IN = 16 * 62, NT_BR = 8 * 8, NT_SQ = 16 * 8, NT_ALL = NT_IN + 3 * NT_BR + 5 * NT_SQ;
            for (int tile = c.bid; tile < NT_ALL; tile += c.nb) {
                const float* src; bf16_t* dst; const float* gain = nullptr; int K, N, tl = tile, mode = 0;
                if (tl < NT_IN) { src = L.w_in; dst = wt; K = D_; N = NIN; gain = L.ln_mix; }
                else if ((tl -= NT_IN) < 3 * NT_BR) { const int bb = tl / NT_BR; tl -= bb * NT_BR; src = L.w_br[0]; if (bb == 1) src = L.w_br[1]; if (bb == 2) src = L.w_br[2]; dst = WSP(bf16_t, WS_WT_BR) + (size_t)bb * D_ * 512; K = 512; N = D_; }
                else { tl -= 3 * NT_BR; const int mm = tl / NT_SQ; tl -= mm * NT_SQ; K = D_; N = D_;
                    src = L.w_out; dst = WSP(bf16_t, WS_WT_OUT);
                    if (mm == 1) { src = L.w_xq; dst = WSP(bf16_t, WS_WT_XQ); gain = L.ln_xq; } if (mm == 2) { src = L.w_xk; dst = WSP(bf16_t, WS_WT_XK); }
                    if (mm == 3) { src = L.w_xv; dst = WSP(bf16_t, WS_WT_XV); } if (mm == 4) { src = L.w_xo; dst = WSP(bf16_t, WS_WT_XO); } }
                const int nkt = K / 64, kt = tl % nkt, nb = tl / nkt, k0 = kt * 64, n0 = nb * 128;
                if (tile < NT_IN) { if (nb >= 16 && nb < 24) mode = 1; else if (nb >= 32 && nb < 37) mode = 2; }
                __syncthreads();
#pragma unroll
                for (int i = 0; i < 4; ++i) { const int kr = (tid >> 5) + 16 * i, nc = 4 * (tid & 31); const f32x4 v = *(const f32x4*)(src + (size_t)(k0 + kr) * N + n0 + nc) * (gain ? gain[k0 + kr] : 1.0f);
                    Ls[kr * 129 + nc] = v[0]; Ls[kr * 129 + nc + 1] = v[1]; Ls[kr * 129 + nc + 2] = v[2]; Ls[kr * 129 + nc + 3] = v[3]; }
                __syncthreads();
                const int j = tid >> 2, kq = tid & 3; int sj = j;
                if (mode == 1) sj = (j & 1) ? 64 + (j >> 1) : (j >> 1);
                if (mode == 2) { const int jj = j & 63; sj = (j & 64) + ((jj & 1) ? 32 + (jj >> 1) : (jj >> 1)); }
                u32x4 o0, o1;
#pragma unroll
                for (int i = 0; i < 4; ++i) { o0[i] = pk2bf(Ls[(16 * kq + 2 * i) * 129 + sj], Ls[(16 * kq + 2 * i + 1) * 129 + sj]); o1[i] = pk2bf(Ls[(16 * kq + 8 + 2 * i) * 129 + sj], Ls[(16 * kq + 9 + 2 * i) * 129 + sj]); }
                bf16_t* dp = dst + (size_t)(n0 + j) * K + k0 + 16 * kq; *(u32x4*)dp = o0; *(u32x4*)(dp + 8) = o1;
            }
            __syncthreads();
        }
#endif
        float* lb = WSP(float, WS_LB);
        for (int i = c.gtid; i < 512; i += c.gsize) { float mx = -1e30f; for (int d = 0; d < DEPTH; ++d) mx = fmaxf(mx, L.lb_param[d * 512 + i]);
            float den = 0.f, num = 0.f; for (int d = 0; d < DEPTH; ++d) { const float ev = expf(L.lb_param[d * 512 + i] - mx); den += ev; if (d >= 1 && d <= l) num += ev; } lb[l * 512 + i] = num / den; }
        rmsnorm_rows_bf16(c, p.in[1], L.ln_xkv, WSP(bf16_t, WS_HM), NMEM);
        if (l == 0) {
#ifdef EMU
            for (int r = c.gtid; r < T; r += c.gsize) { float q = 0.f; for (int i = 0; i < D_; ++i) { const float x = xsrc[(size_t)r * D_ + i]; q += x * x; HB[(size_t)r * D_ + i] = f2bf(x); } SS[(size_t)r * SSW] = q; }
#else
            { const int lane = c.tid & 63, gw = c.gtid >> 6, nw = c.gsize >> 6;
              for (int r = gw; r < T; r += nw) { const f32x4* xr = (const f32x4*)(xsrc + (size_t)r * D_) + lane; float q = 0.f;
#pragma unroll
                  for (int j = 0; j < 4; ++j) { const f32x4 v = xr[64 * j]; q += (v[0] * v[0] + v[1] * v[1]) + (v[2] * v[2] + v[3] * v[3]); unsigned* o = (unsigned*)(HB + (size_t)r * D_ + 4 * lane + 256 * j); o[0] = pk2bf(v[0], v[1]); o[1] = pk2bf(v[2], v[3]); }
                  q = wave_sum(q); if (lane < 4) ((f32x4*)(SS + (size_t)r * SSW))[lane] = (f32x4){lane == 0 ? q : 0.f, 0.f, 0.f, 0.f}; } }
#endif
        }
    } break;
    case 1: {
        bf16_t* we = WSP(bf16_t, WS_WT_EFF);
#ifdef EMU
        for (long i = c.gtid; i < 2048L * D_; i += c.gsize) { const int n = (int)(i / D_), k = (int)(i % D_); const int h = n >> 8, pp = (n >> 7) & 1, key = n & 127;
            const float* wq = L.peer_wq + (size_t)k * 2048 + h * 256 + pp * 128; const float* kk = L.peer_keys + ((size_t)(pp * 8 + h) * 128 + key) * 128;
            float sacc = 0.f; for (int d = 0; d < 128; ++d) sacc += wq[d] * kk[d]; we[i] = f2bf(sacc * L.ln_ffn[k]); }
#else
        {
            float* Ks = (float*)g_lds; float* Ws = Ks + 128 * 128; const int tid = c.tid, tx = tid & 31, ty = tid >> 5;
            for (int task = c.bid; task < 256; task += c.nb) { const int hp = task >> 4, k0 = (task & 15) * 64, h = hp >> 1, pp = hp & 1;
                const float* kb = L.peer_keys + (size_t)(pp * 8 + h) * 128 * 128; const float* wb = L.peer_wq + (size_t)k0 * 2048 + hp * 128;
                __syncthreads();
                for (int i = tid; i < 128 * 32; i += NTHREADS) { const int key = i & 127, d4 = (i >> 7) * 4; const f32x4 v = *(const f32x4*)(kb + (size_t)key * 128 + d4);
                    Ks[(d4 + 0) * 128 + key] = v[0]; Ks[(d4 + 1) * 128 + key] = v[1]; Ks[(d4 + 2) * 128 + key] = v[2]; Ks[(d4 + 3) * 128 + key] = v[3]; }
                for (int i = tid; i < 64 * 32; i += NTHREADS) { const int kk = i & 63, d4 = (i >> 6) * 4; const f32x4 v = *(const f32x4*)(wb + (size_t)kk * 2048 + d4);
                    Ws[(d4 + 0) * 64 + kk] = v[0]; Ws[(d4 + 1) * 64 + kk] = v[1]; Ws[(d4 + 2) * 64 + kk] = v[2]; Ws[(d4 + 3) * 64 + kk] = v[3]; }
                __syncthreads();
                float acc[4][4];
#pragma unroll
                for (int i = 0; i < 4; ++i)
#pragma unroll
                    for (int j = 0; j < 4; ++j) acc[i][j] = 0.f;
#pragma unroll 4
                for (int d = 0; d < 128; ++d) { const f32x4 kv = *(const f32x4*)(Ks + d * 128 + 4 * tx), wv = *(const f32x4*)(Ws + d * 64 + 4 * ty);
#pragma unroll
                    for (int i = 0; i < 4; ++i)
#pragma unroll
                        for (int j = 0; j < 4; ++j) acc[i][j] += kv[i] * wv[j]; }
                { const f32x4 gf = *(const f32x4*)(L.ln_ffn + k0 + 4 * ty);
#pragma unroll
                for (int i = 0; i < 4; ++i) { unsigned* o = (unsigned*)(we + (size_t)(hp * 128 + 4 * tx + i) * D_ + k0 + 4 * ty); o[0] = pk2bf(acc[i][0] * gf[0], acc[i][1] * gf[1]); o[1] = pk2bf(acc[i][2] * gf[2], acc[i][3] * gf[3]); } }
            }
            __syncthreads();
        }
#endif
#ifdef EMU
        { EpiKXh e{WSP(bf16_t, WS_KX)}; gemm_bf16(c, WSP(bf16_t, WS_HM), D_, WSP(bf16_t, WS_WT_XK), NMEM, D_, D_, e); }
        { EpiVXT e{WSP(bf16_t, WS_VX)}; gemm_bf16(c, WSP(bf16_t, WS_HM), D_, WSP(bf16_t, WS_WT_XV), NMEM, D_, D_, e); }
#endif
#ifdef EMU
        { EpiInProj e{P, WSP(float, WS_LOGF), WSP(float, WS_LB) + l * 512, pos, SS + (size_t)(3 * l) * T * SSW}; gemm_bf16(c, HB, D_, WSP(bf16_t, WS_WT_IN), T, NIN, D_, e); }
#else
        { static_assert(WS_WT_XV == WS_WT_XK + (size_t)D_ * D_ * 2, "w_xk and w_xv copies must be adjacent: the rider units see them as one [2048][1024] matrix");
          pg8::Gemm g{HB, WSP(bf16_t, WS_WT_IN), T, NIN, D_, D_, 0, (size_t)((const char*)WSP(bf16_t, WS_HM) - (const char*)HB), (size_t)((const char*)WSP(bf16_t, WS_WT_XK) - (const char*)WSP(bf16_t, WS_WT_IN))};
          pg8::PlusOrder S; S.init(T, NIN, c.nb, c.bid, 8); prep_rstd(c, SS + (size_t)(3 * l) * T * SSW, WSP(float, WS_RS) + (size_t)(3 * l) * T, S.base);
          EpiInProjPg8 e{P, WSP(float, WS_LOGF), WSP(float, WS_LB) + l * 512, pos, WSP(float, WS_RS) + (size_t)(3 * l) * T, WSP(bf16_t, WS_KX), WSP(bf16_t, WS_VX)};
          pg8::gemm_phase<EpiInProjPg8, pg8::PlusOrder, true, true>((PG8_LAS unsigned char*)g_lds, g, S, e, c.tid); __syncthreads(); }
#endif
    } break;
    case 2: {
        const int NC = T / 64; const float* lgf = WSP(float, WS_LOGF);
        bf16_t* KT = (bf16_t*)p.out; bf16_t* VT = WSP(bf16_t, WS_VT); float* VEC = WSP(float, WS_VEC);
        for (long w = c.gtid; w < (long)8 * NC * 64; w += c.gsize) {
            const int u = (int)(w >> 6), lane = (int)(w & 63); const int bh = u / NC, cc = u % NC, br = bh >> 2, h = bh & 3; const int t0 = cc * 64, col = 2 * lane;
            const int qcol = (br ? C_RQ : C_HQ) + h * 128 + col, kcol = (br ? C_RK : C_HF) + h * 128 + col, vcol = (br ? C_RV : C_HI) + h * 128 + col;
            const float lgam = logf(1.0f - exp2f(-5.0f - (float)h));
            float b0, b1, last0, last1;
            if (br == 0) { float s0 = 0.f, s1 = 0.f; b0 = 0.f; b1 = 0.f;
#pragma unroll 1
                for (int j0 = 0; j0 < 64; j0 += 16) { float lv0[16], lv1[16];
#pragma unroll
                    for (int jj = 0; jj < 16; ++jj) { const float* lf = lgf + (size_t)(t0 + j0 + jj) * 512 + h * 128 + col; lv0[jj] = lf[0]; lv1[jj] = lf[1]; }
#pragma unroll
                    for (int jj = 0; jj < 16; ++jj) { s0 += lv0[jj]; s1 += lv1[jj]; if (j0 + jj == 31) { b0 = s0; b1 = s1; } } }
                last0 = s0; last1 = s1; }
            else { b0 = b1 = 32.0f * lgam; last0 = last1 = 64.0f * lgam; }
            float s0 = 0.f, s1 = 0.f;
            float lA0[8], lA1[8], lB0[8], lB1[8]; unsigned qA[8], kA[8], vA[8], qB[8], kB[8], vB[8];
#ifdef EMU
#define PREP_VLOAD(dst, r) dst = *(const unsigned*)(P + PI(r, vcol));
#define PREP_EXP(x) expf(x)
#define PREP_PK(a, b) ((unsigned)f2bf(a) | ((unsigned)f2bf(b) << 16))
#else
#define PREP_VLOAD(dst, r)
#define PREP_EXP(x) __expf(x)
#define PREP_PK(a, b) pk2bf(a, b)
#endif
#define PREP_LOAD(L0, L1, Q, K, V, g) { const float* lfb = lgf + (size_t)(t0 + 8 * (g)) * 512 + h * 128 + col; const int r0_ = t0 + 8 * (g); \
                _Pragma("unroll") for (int jj = 0; jj < 8; ++jj) { if (br == 0) { L0[jj] = lfb[jj * 512]; L1[jj] = lfb[jj * 512 + 1]; } \
                    Q[jj] = *(const unsigned*)(P + PI(r0_ + jj, qcol)); K[jj] = *(const unsigned*)(P + PI(r0_ + jj, kcol)); PREP_VLOAD(V[jj], r0_ + jj) } }
#ifdef EMU
#define PREP_PROC(L0, L1, Q, K, V, g) { const int r0_ = t0 + 8 * (g); unsigned ka[4], kb[4], va[4], vb2[4]; \
                _Pragma("unroll") for (int jj = 0; jj < 8; ++jj) { float c0, c1; \
                    if (br == 0) { s0 += L0[jj]; s1 += L1[jj]; c0 = s0; c1 = s1; } else { c0 = c1 = (float)(8 * (g) + jj + 1) * lgam; } \
                    const float q0 = bf2f((bf16_t)(Q[jj] & 0xffffu)) * PREP_EXP(c0 - b0), q1 = bf2f((bf16_t)(Q[jj] >> 16)) * PREP_EXP(c1 - b1); \
                    const unsigned kw = PREP_PK(bf2f((bf16_t)(K[jj] & 0xffffu)) * PREP_EXP(b0 - c0), bf2f((bf16_t)(K[jj] >> 16)) * PREP_EXP(b1 - c1)); \
                    if (!dry) { *(unsigned*)(P + PI(r0_ + jj, qcol)) = PREP_PK(q0, q1); *(unsigned*)(P + PI(r0_ + jj, kcol)) = kw; } \
                    if (jj & 1) { ka[jj >> 1] |= kw << 16; kb[jj >> 1] |= kw & 0xffff0000u; va[jj >> 1] |= V[jj] << 16; vb2[jj >> 1] |= V[jj] & 0xffff0000u; } \
                    else { ka[jj >> 1] = kw & 0xffffu; kb[jj >> 1] = kw >> 16; va[jj >> 1] = V[jj] & 0xffffu; vb2[jj >> 1] = V[jj] >> 16; } } \
                unsigned* d0 = (unsigned*)(KT + ((size_t)u * 128 + col) * 64 + 8 * (g)); unsigned* e0 = (unsigned*)(VT + ((size_t)u * 128 + col) * 64 + 8 * (g)); \
                _Pragma("unroll") for (int i = 0; i < 4; ++i) { d0[i] = ka[i]; d0[32 + i] = kb[i]; e0[i] = va[i]; e0[32 + i] = vb2[i]; } }
#else
#define PREP_PROC(L0, L1, Q, K, V, g) { const int r0_ = t0 + 8 * (g); \
                _Pragma("unroll") for (int jj = 0; jj < 8; ++jj) { float c0, c1; \
                    if (br == 0) { s0 += L0[jj]; s1 += L1[jj]; c0 = s0; c1 = s1; } else { c0 = c1 = (float)(8 * (g) + jj + 1) * lgam; } \
                    const float q0 = bf2f((bf16_t)(Q[jj] & 0xffffu)) * PREP_EXP(c0 - b0), q1 = bf2f((bf16_t)(Q[jj] >> 16)) * PREP_EXP(c1 - b1); \
                    const unsigned kw = PREP_PK(bf2f((bf16_t)(K[jj] & 0xffffu)) * PREP_EXP(b0 - c0), bf2f((bf16_t)(K[jj] >> 16)) * PREP_EXP(b1 - c1)); \
                    if (!dry) { *(unsigned*)(P + PI(r0_ + jj, qcol)) = PREP_PK(q0, q1); *(unsigned*)(P + PI(r0_ + jj, kcol)) = kw; } \
                    wk[(8 * (g) + jj) * 64 + lane] = kw; } }
#endif
#ifndef EMU
            unsigned* wk = (unsigned*)(g_lds + (c.tid >> 6) * 16384);
#endif
            PREP_LOAD(lA0, lA1, qA, kA, vA, 0)
#pragma unroll 1
            for (int g = 0; g < 8; g += 2) {
                PREP_LOAD(lB0, lB1, qB, kB, vB, g + 1)
                PREP_PROC(lA0, lA1, qA, kA, vA, g)
                if (g + 2 < 8) PREP_LOAD(lA0, lA1, qA, kA, vA, g + 2)
                PREP_PROC(lB0, lB1, qB, kB, vB, g + 1)
            }
#undef PREP_LOAD
#undef PREP_PROC
#undef PREP_VLOAD
#ifndef EMU
            { bf16_t* dstT = KT + ((size_t)u * 128 + col) * 64;
#pragma unroll
              for (int g2 = 0; g2 < 8; ++g2) { u32x4 lo, hi;
#pragma unroll
                  for (int i = 0; i < 4; ++i) { const unsigned w0 = wk[(8 * g2 + 2 * i) * 64 + lane], w1 = wk[(8 * g2 + 2 * i + 1) * 64 + lane]; lo[i] = (w0 & 0xffffu) | (w1 << 16); hi[i] = (w0 >> 16) | (w1 & 0xffff0000u); }
                  *(u32x4*)(dstT + 8 * g2) = lo; *(u32x4*)(dstT + 64 + 8 * g2) = hi; } }
            { unsigned vw[64];
#pragma unroll
              for (int j = 0; j < 64; ++j) vw[j] = *(const unsigned*)(P + PI(t0 + j, vcol));
              bf16_t* dstT = VT + ((size_t)u * 128 + col) * 64;
#pragma unroll
              for (int g2 = 0; g2 < 8; ++g2) { u32x4 lo, hi;
#pragma unroll
                  for (int i = 0; i < 4; ++i) { const unsigned w0 = vw[8 * g2 + 2 * i], w1 = vw[8 * g2 + 2 * i + 1]; lo[i] = (w0 & 0xffffu) | (w1 << 16); hi[i] = (w0 >> 16) | (w1 & 0xffff0000u); }
                  *(u32x4*)(dstT + 8 * g2) = lo; *(u32x4*)(dstT + 64 + 8 * g2) = hi; } }
#endif
#undef PREP_EXP
#undef PREP_PK
            float* vb = VEC + (size_t)u * 384; vb[2 * col] = expf(last0); vb[2 * col + 1] = expf(b0); vb[2 * col + 2] = expf(last1); vb[2 * col + 3] = expf(b1); vb[256 + col] = expf(last0 - b0); vb[256 + col + 1] = expf(last1 - b1);
        }
#ifdef EMU
        for (long w = c.gtid; w < (long)T * 8; w += c.gsize) {
            const int t = (int)(w >> 3), h = (int)(w & 7), kvh = h >> 2; float q[64], acc[64];
#pragma unroll
            for (int d = 0; d < 64; ++d) { q[d] = bf2f(P[PI(t, C_SQ + h * 64 + d)]); acc[d] = 0.f; }
            float m = L.sinks[h], lsum = 1.0f;
            const int s0 = t - 127 > 0 ? t - 127 : 0;
            for (int s2 = s0; s2 <= t; ++s2) { const bf16_t* kr = P + PI(s2, C_SK + kvh * 64); const bf16_t* vr = P + PI(s2, C_SV + kvh * 64); float sc = 0.f;
#pragma unroll
                for (int d = 0; d < 64; ++d) sc += q[d] * bf2f(kr[d]);
                const float mn = fmaxf(m, sc), al = expf(m - mn), pe = expf(sc - mn); lsum = lsum * al + pe; m = mn;
#pragma unroll
                for (int d = 0; d < 64; ++d) acc[d] = acc[d] * al + pe * bf2f(vr[d]); }
            const float inv = 1.0f / lsum;
#pragma unroll
            for (int d = 0; d < 64; ++d) OBUF[(size_t)t * 1536 + 1024 + h * 64 + d] = f2bf(acc[d] * inv);
        }
#else
        { bf16_t* SVT = WSP(bf16_t, WS_SVT);
          for (long w = c.gtid; w < (long)2 * NC * 64; w += c.gsize) { const int u = (int)(w >> 6), d = (int)(w & 63), kvh = u / NC, t0 = (u % NC) * 64;
              { unsigned sv[64];
#pragma unroll
                for (int j = 0; j < 64; ++j) sv[j] = P[PI(t0 + j, C_SV + kvh * 64 + d)];
#pragma unroll
                for (int g = 0; g < 8; ++g) *(u32x4*)(SVT + ((size_t)kvh * 64 + d) * T + t0 + 8 * g) = (u32x4){sv[8 * g] | (sv[8 * g + 1] << 16), sv[8 * g + 2] | (sv[8 * g + 3] << 16), sv[8 * g + 4] | (sv[8 * g + 5] << 16), sv[8 * g + 6] | (sv[8 * g + 7] << 16)}; } } }
#endif
    } break;
    case 3: {
        const int NC = T / 64; bf16_t* LS = WSP(bf16_t, WS_LS);
        EpiLS e{LS, WSP(float, WS_VEC)};
        gemm_bf16_batched(c, WSP(bf16_t, WS_VT), 64, (const bf16_t*)p.out, 128, 128, 64, 8 * NC, (size_t)128 * 64, (size_t)128 * 64, e);
#ifndef EMU
        {
            const bf16_t* SVT = WSP(bf16_t, WS_SVT); const int lane = c.tid & 63, fr = lane & 15, fq = lane >> 4, gw = c.gtid >> 6, nw = c.gsize >> 6;
            typedef short s16x4 __attribute__((ext_vector_type(4)));
            for (int wt = gw; wt < 2 * (T / 16); wt += nw) { const int g = wt & 1, t0 = (wt >> 1) * 16, kb = t0 - 128;
                bf16x8 kf[9][2];
#pragma unroll
                for (int kt = 0; kt < 9; ++kt) { int srow = kb + 16 * kt + fr; srow = srow < 0 ? 0 : srow;
#pragma unroll
                    for (int ks = 0; ks < 2; ++ks) kf[kt][ks] = *(const bf16x8*)(P + PI(srow, C_SK + g * 64 + 32 * ks + 8 * fq)); }
#pragma unroll 1
                for (int qh = 0; qh < 4; ++qh) { const int h = 4 * g + qh; const float sink = L.sinks[h];
                    bf16x8 qf[2];
#pragma unroll
                    for (int ks = 0; ks < 2; ++ks) qf[ks] = *(const bf16x8*)(P + PI(t0 + fr, C_SQ + h * 64 + 32 * ks + 8 * fq));
                    f32x4 st[9]; float m = sink;
#pragma unroll
                    for (int kt = 0; kt < 9; ++kt) { st[kt] = (f32x4){0.f, 0.f, 0.f, 0.f};
#pragma unroll
                        for (int ks = 0; ks < 2; ++ks) st[kt] = __builtin_amdgcn_mfma_f32_16x16x32_bf16(kf[kt][ks], qf[ks], st[kt], 0, 0, 0);
#pragma unroll
                        for (int r = 0; r < 4; ++r) { const int srow = kb + 16 * kt + 4 * fq + r, rel = t0 + fr - srow; const bool ok = (srow >= 0) && (rel >= 0) && (rel < 128);
                            st[kt][r] = ok ? st[kt][r] : -1e30f; m = fmaxf(m, st[kt][r]); } }
                    m = fmaxf(m, shx<16>(m)); m = max32(m);
                    float lsum = 0.f;
#pragma unroll
                    for (int kt = 0; kt < 9; ++kt)
#pragma unroll
                        for (int r = 0; r < 4; ++r) { const float pe = __expf(st[kt][r] - m); st[kt][r] = pe; lsum += pe; }
                    lsum += shx<16>(lsum); lsum = add32(lsum); lsum += __expf(sink - m);
                    const float inv = 1.0f / lsum;
                    bf16x8 pf[5];
#pragma unroll
                    for (int pp = 0; pp < 5; ++pp) { bf16x8 f;
#pragma unroll
                        for (int e2 = 0; e2 < 8; ++e2) { const int kt = 2 * pp + (e2 >> 2); f[e2] = (kt < 9) ? (short)f2bf(st[kt < 9 ? kt : 0][e2 & 3]) : (short)0; }
                        pf[pp] = f; }
#pragma unroll
                    for (int dt = 0; dt < 4; ++dt) { f32x4 oacc = (f32x4){0.f, 0.f, 0.f, 0.f}; const bf16_t* vrow = SVT + ((size_t)g * 64 + 16 * dt + fr) * T;
#pragma unroll
                        for (int pp = 0; pp < 5; ++pp) { int s8 = kb + 32 * pp + 4 * fq; const int sa = s8 < 0 ? 0 : s8; const s16x4 lo = *(const s16x4*)(vrow + sa); s16x4 hi = (s16x4){0, 0, 0, 0};
                            if (pp < 4) { const int sb = s8 + 16 < 0 ? 0 : s8 + 16; hi = *(const s16x4*)(vrow + sb); }
                            bf16x8 vf; vf[0] = lo[0]; vf[1] = lo[1]; vf[2] = lo[2]; vf[3] = lo[3]; vf[4] = hi[0]; vf[5] = hi[1]; vf[6] = hi[2]; vf[7] = hi[3];
                            oacc = __builtin_amdgcn_mfma_f32_16x16x32_bf16(vf, pf[pp], oacc, 0, 0, 0); }
                        unsigned* dst = (unsigned*)(OBUF + (size_t)(t0 + fr) * 1536 + 1024 + h * 64 + 16 * dt + 4 * fq);
                        dst[0] = pk2bf(oacc[0] * inv, oacc[1] * inv); dst[1] = pk2bf(oacc[2] * inv, oacc[3] * inv); }
                }
            }
        }
#endif
    } break;
    case 4: {
        const int NC = T / 64; bf16_t* LS = WSP(bf16_t, WS_LS); const float* VEC = WSP(float, WS_VEC);
        { constexpr int UB = (T_ / 64) % 32 == 0 ? 16 : 2; struct f32x4s { float x, y, z, w; };
#ifdef EMU
          const long e_lo = c.gtid, e_step = c.gsize;
#else
          const long e_lo = (c.tid < 256) ? (long)c.bid * 256 + c.tid : (1L << 40), e_step = (long)c.nb * 256;
#endif
          for (long e = e_lo; e < 8L * 128 * 64; e += e_step) { const int kp = (int)(e & 63), vv = (int)((e >> 6) & 127), bh = (int)(e >> 13); float st0 = 0.f, st1 = 0.f;
            unsigned lvA[UB], lvB[UB]; f32x4s vA[UB], vB[UB];
#define SCAN_LOAD(lv, vv4, cb0) _Pragma("unroll") for (int i = 0; i < UB; ++i) { const int u = bh * NC + (cb0) + i; lv[i] = *((const unsigned*)(LS + ((size_t)u * 128 + vv) * 128) + kp); vv4[i] = *(const f32x4s*)(VEC + (size_t)u * 384 + 4 * kp); }
#define SCAN_PROC(lv, vv4, cb0) _Pragma("unroll") for (int i = 0; i < UB; ++i) { const int u = bh * NC + (cb0) + i; unsigned* ls = (unsigned*)(LS + ((size_t)u * 128 + vv) * 128) + kp; \
                if (!dry) *ls = (unsigned)f2bf(vv4[i].y * st0) | ((unsigned)f2bf(vv4[i].w * st1) << 16); \
                st0 = vv4[i].x * st0 + bf2f((bf16_t)(lv[i] & 0xffffu)); st1 = vv4[i].z * st1 + bf2f((bf16_t)(lv[i] >> 16)); }
            SCAN_LOAD(lvA, vA, 0)
#pragma unroll 1
            for (int cb = 0; cb < NC; cb += 2 * UB) {
                if (cb + UB < NC) { SCAN_LOAD(lvB, vB, cb + UB) }
                SCAN_PROC(lvA, vA, cb)
                if (cb + 2 * UB < NC) { SCAN_LOAD(lvA, vA, cb + 2 * UB) }
                if (cb + UB < NC) { SCAN_PROC(lvB, vB, cb + UB) }
            }
#undef SCAN_LOAD
#undef SCAN_PROC
            if (dry && st0 + st1 == 12345.678f) LS[0] = 0; } }
        unsigned char* tu = WSP(unsigned char, WS_TABU); unsigned char* tv = WSP(unsigned char, WS_TABV);
#ifdef EMU
#if PEER_FP4
        for (long i = c.gtid; i < 16384L * D_ / 2; i += c.gsize) { const long e0 = 2 * i; tu[i] = (unsigned char)(f2fp4_sw(L.peer_u[e0] * L.ln_ffn[e0 & 1023] * PEER_U_SCALE) | (f2fp4_sw(L.peer_u[e0 + 1] * L.ln_ffn[(e0 + 1) & 1023] * PEER_U_SCALE) << 4));
            tv[i] = (unsigned char)(f2fp4_sw(L.peer_v[e0] * PEER_V_SCALE) | (f2fp4_sw(L.peer_v[e0 + 1] * PEER_V_SCALE) << 4)); }
#else
        for (long i = c.gtid; i < 16384L * D_; i += c.gsize) { tu[i] = f2fp8_sw(L.peer_u[i] * L.ln_ffn[i & 1023] * PEER_U_SCALE); tv[i] = f2fp8_sw(L.peer_v[i] * PEER_V_SCALE); }
#endif
#else
#if PEER_FP4
        {
            const int lane = c.tid & 63, wv = c.tid >> 6, gw = c.gtid >> 6, nw = c.gsize >> 6; unsigned char* wl = g_lds + wv * 1024;
            f32x4 gf[4];
#pragma unroll
            for (int k = 0; k < 4; ++k) gf[k] = ((const f32x4*)L.ln_ffn)[64 * k + lane] * PEER_U_SCALE;
            for (int row = gw; row < 16384; row += nw) { const f32x4* ur = (const f32x4*)(L.peer_u + (size_t)row * D_); const f32x4* vr = (const f32x4*)(L.peer_v + (size_t)row * D_); f32x4 a[4], b[4];
#pragma unroll
                for (int k = 0; k < 4; ++k) { a[k] = ur[64 * k + lane]; b[k] = vr[64 * k + lane]; }
#pragma unroll
                for (int k = 0; k < 4; ++k) { a[k] = a[k] * gf[k]; b[k] = b[k] * PEER_V_SCALE; unsigned x = 0, y = 0;
                    x = __builtin_amdgcn_cvt_scalef32_pk_fp4_f32(x, a[k][0], a[k][1], 1.0f, 0); x = __builtin_amdgcn_cvt_scalef32_pk_fp4_f32(x, a[k][2], a[k][3], 1.0f, 1);
                    y = __builtin_amdgcn_cvt_scalef32_pk_fp4_f32(y, b[k][0], b[k][1], 1.0f, 0); y = __builtin_amdgcn_cvt_scalef32_pk_fp4_f32(y, b[k][2], b[k][3], 1.0f, 1);
                    *(unsigned short*)(wl + 128 * k + 2 * lane) = (unsigned short)x; *(unsigned short*)(wl + 512 + 128 * k + 2 * lane) = (unsigned short)y; }
                asm volatile("" ::: "memory");
                const unsigned long long ou = *(const unsigned long long*)(wl + 8 * lane), ov = *(const unsigned long long*)(wl + 512 + 8 * lane);
                asm volatile("" ::: "memory");
                ((unsigned long long*)(tu + (size_t)row * PEER_ROWB))[lane] = ou; ((unsigned long long*)(tv + (size_t)row * PEER_ROWB))[lane] = ov; }
            __syncthreads();
        }
#else
        for (long i = c.gtid; i < 16384L * D_ / 16; i += c.gsize) {
            f32x4 a[4], b[4];
#pragma unroll
            for (int k = 0; k < 4; ++k) { a[k] = ((const f32x4*)L.peer_u)[4 * i + k] * ((const f32x4*)L.ln_ffn)[(4 * i + k) & 255] * PEER_U_SCALE; b[k] = ((const f32x4*)L.peer_v)[4 * i + k] * PEER_V_SCALE; }
#if PEER_FP4
            unsigned wu[2], wv[2];
#pragma unroll
            for (int hh = 0; hh < 2; ++hh) { unsigned x = 0, y = 0;
                x = __builtin_amdgcn_cvt_scalef32_pk_fp4_f32(x, a[2 * hh][0], a[2 * hh][1], 1.0f, 0); x = __builtin_amdgcn_cvt_scalef32_pk_fp4_f32(x, a[2 * hh][2], a[2 * hh][3], 1.0f, 1);
                x = __builtin_amdgcn_cvt_scalef32_pk_fp4_f32(x, a[2 * hh + 1][0], a[2 * hh + 1][1], 1.0f, 2); x = __builtin_amdgcn_cvt_scalef32_pk_fp4_f32(x, a[2 * hh + 1][2], a[2 * hh + 1][3], 1.0f, 3);
                y = __builtin_amdgcn_cvt_scalef32_pk_fp4_f32(y, b[2 * hh][0], b[2 * hh][1], 1.0f, 0); y = __builtin_amdgcn_cvt_scalef32_pk_fp4_f32(y, b[2 * hh][2], b[2 * hh][3], 1.0f, 1);
                y = __builtin_amdgcn_cvt_scalef32_pk_fp4_f32(y, b[2 * hh + 1][0], b[2 * hh + 1][1], 1.0f, 2); y = __builtin_amdgcn_cvt_scalef32_pk_fp4_f32(y, b[2 * hh + 1][2], b[2 * hh + 1][3], 1.0f, 3);
                wu[hh] = x; wv[hh] = y; }
            ((unsigned long long*)tu)[i] = (unsigned long long)wu[0] | ((unsigned long long)wu[1] << 32); ((unsigned long long*)tv)[i] = (unsigned long long)wv[0] | ((unsigned long long)wv[1] << 32);
#else
            u32x4 wu, wv;
#pragma unroll
            for (int k = 0; k < 4; ++k) { int x = 0; x = __builtin_amdgcn_cvt_pk_fp8_f32(a[k][0], a[k][1], x, false); x = __builtin_amdgcn_cvt_pk_fp8_f32(a[k][2], a[k][3], x, true); wu[k] = (unsigned)x;
                int y = 0; y = __builtin_amdgcn_cvt_pk_fp8_f32(b[k][0], b[k][1], y, false); y = __builtin_amdgcn_cvt_pk_fp8_f32(b[k][2], b[k][3], y, true); wv[k] = (unsigned)y; }
            ((u32x4*)tu)[i] = wu; ((u32x4*)tv)[i] = wv;
#endif
        }
#endif
#endif
    } break;
    case 5: {
        const int NC = T / 64; const bf16_t* LS = WSP(bf16_t, WS_LS); const bf16_t* VT = WSP(bf16_t, WS_VT); bf16_t* OR = ((bf16_t*)p.out + (size_t)T * D_);
#ifdef EMU
        for (long w = c.gtid; w < (long)8 * NC * 64; w += c.gsize) { const int u = (int)(w >> 6), i = (int)(w & 63); const int bh = u / NC, cc = u % NC, br = bh >> 2, h = bh & 3, t0 = cc * 64;
            const int qcol = (br ? C_RQ : C_HQ) + h * 128, kcol = (br ? C_RK : C_HF) + h * 128; const bf16_t* qr = P + PI(t0 + i, qcol); float sc[64];
            for (int j = 0; j <= i; ++j) { const bf16_t* kr = P + PI(t0 + j, kcol); float a = 0.f; for (int k = 0; k < 128; ++k) a += bf2f(qr[k]) * bf2f(kr[k]); sc[j] = bf2f(f2bf(a)); }
            for (int vv = 0; vv < 128; ++vv) { float o = 0.f; const bf16_t* sr = LS + ((size_t)u * 128 + vv) * 128; for (int k = 0; k < 128; ++k) o += bf2f(qr[k]) * bf2f(sr[k]);
                const bf16_t* vr = VT + ((size_t)u * 128 + vv) * 64; for (int j = 0; j <= i; ++j) o += sc[j] * bf2f(vr[j]);
                OR[(size_t)(t0 + i) * 1024 + br * 512 + h * 128 + vv] = f2bf(o); } }
#else
        const int lane = c.tid & 63, fr = lane & 15, fq = lane >> 4; const int gw = c.gtid >> 6, nw = c.gsize >> 6;
        for (int wt = gw; wt < 8 * NC; wt += nw) { const int u = wt; const int bh = u / NC, cc = u % NC, br = bh >> 2, h = bh & 3, t0     = cc * 64;
            const int qcol = (br ? C_RQ : C_HQ) + h * 128, kcol = (br ? C_RK : C_HF) + h * 128;
            bf16x8 qf[4][4];
#pragma unroll
            for (int I = 0; I < 4; ++I)
#pragma unroll
                for (int ks = 0; ks < 4; ++ks) qf[I][ks] = *(const bf16x8*)(P + PI(t0 + 16 * I + fr, qcol + 32 * ks + 8 * fq));
            f32x4 st[10];
#pragma unroll
            for (int i = 0; i < 10; ++i) st[i] = (f32x4){0.f, 0.f, 0.f, 0.f};
#pragma unroll
            for (int ks = 0; ks < 4; ++ks) { bf16x8 kf[4];
#pragma unroll
                for (int J = 0; J < 4; ++J) kf[J] = *(const bf16x8*)(P + PI(t0 + 16 * J + fr, kcol + 32 * ks + 8 * fq));
#pragma unroll
                for (int I = 0; I < 4; ++I)
#pragma unroll
                    for (int J = 0; J <= I; ++J) st[I * (I + 1) / 2 + J] = __builtin_amdgcn_mfma_f32_16x16x32_bf16(kf[J], qf[I][ks], st[I * (I + 1) / 2 + J], 0, 0, 0); }
#pragma unroll
            for (int I = 0; I < 4; ++I)
#pragma unroll
                for (int r = 0; r < 4; ++r) if (4 * fq + r > fr) st[I * (I + 1) / 2 + I][r] = 0.f;
            bf16x8 pf[4][2];
#pragma unroll
            for (int I = 0; I < 4; ++I)
#pragma unroll
                for (int pp = 0; pp < 2; ++pp) { bf16x8 f;
#pragma unroll
                    for (int e2 = 0; e2 < 8; ++e2) { const int J = 2 * pp + (e2 >> 2); f[e2] = (J <= I) ? (short)f2bf(st[I * (I + 1) / 2 + (J <= I ? J : 0)][e2 & 3]) : (short)0; }
                    pf[I][pp] = f; }
#pragma unroll 2
            for (int vt = 0; vt < 8; ++vt) { f32x4 oacc[4];
#pragma unroll
                for (int I = 0; I < 4; ++I) oacc[I] = (f32x4){0.f, 0.f, 0.f, 0.f};
#pragma unroll
                for (int ks = 0; ks < 4; ++ks) { const bf16x8 sf = *(const bf16x8*)(LS + ((size_t)u * 128 + 16 * vt + fr) * 128 + 32 * ks + 8 * fq);
#pragma unroll
                    for (int I = 0; I < 4; ++I) oacc[I] = __builtin_amdgcn_mfma_f32_16x16x32_bf16(sf, qf[I][ks], oacc[I], 0, 0, 0); }
#pragma unroll
                for (int pp = 0; pp < 2; ++pp) { const bf16_t* vb = VT + ((size_t)u * 128 + 16 * vt + fr) * 64 + 32 * pp + 4 * fq;
                    typedef short s16x4 __attribute__((ext_vector_type(4)));
                    const s16x4 lo = *(const s16x4*)vb, hi = *(const s16x4*)(vb + 16); bf16x8 vf; vf[0] = lo[0]; vf[1] = lo[1]; vf[2] = lo[2]; vf[3] = lo[3]; vf[4] = hi[0]; vf[5] = hi[1]; vf[6] = hi[2]; vf[7] = hi[3];
#pragma unroll
                    for (int I = 0; I < 4; ++I) if (2 * pp <= I) oacc[I] = __builtin_amdgcn_mfma_f32_16x16x32_bf16(vf, pf[I][pp], oacc[I], 0, 0, 0); }
#pragma unroll
                for (int I = 0; I < 4; ++I) { unsigned* dst = (unsigned*)(OR + (size_t)(t0 + 16 * I + fr) * 1024 + br * 512 + h * 128 + 16 * vt + 4 * fq);
                    dst[0] = (unsigned)f2bf(oacc[I][0]) | ((unsigned)f2bf(oacc[I][1]) << 16); dst[1] = (unsigned)f2bf(oacc[I][2]) | ((unsigned)f2bf(oacc[I][3]) << 16); }
            }
        }
#endif
    } break;
    case 6: {
#ifdef EMU
        const bf16_t* oraw = ((bf16_t*)p.out + (size_t)T * D_);
        for (int r = c.gtid; r < T; r += c.gsize) { const bf16_t* orow = oraw + (size_t)r * D_; float ss = 0.f; for (int i = 0; i < 512; ++i) ss += bf2f(orow[i]) * bf2f(orow[i]);
            const float rs = 1.0f / sqrtf(ss * (1.0f / 512.0f) + 1e-6f);
            for (int i = 0; i < 512; ++i) OBUF[(size_t)r * 1536 + i] = f2bf(bf2f(orow[i]) * rs * L.hgrn_norm[i] * bf2f(P[PI(r, C_HG + i)])); }
        for (long w = c.gtid; w < (long)T * 4; w += c.gsize) { const int r = (int)(w >> 2), h = (int)(w & 3); const bf16_t* orow = oraw + (size_t)r * D_ + 512 + h * 128; float ss = 0.f;
            for (int i = 0; i < 128; ++i) ss += bf2f(orow[i]) * bf2f(orow[i]);
            const float rs = 1.0f / sqrtf(ss * (1.0f / 128.0f) + 1e-6f);
            for (int i = 0; i < 128; ++i) OBUF[(size_t)r * 1536 + 512 + h * 128 + i] = f2bf(bf2f(orow[i]) * rs * bf2f(P[PI(r, C_RG + h * 128 + i)])); }
    #else
        { const bf16_t* oraw = ((bf16_t*)p.out + (size_t)T * D_); const int lane = c.tid & 63, gw = c.gtid >> 6, nw = c.gsize >> 6;
          for (int r = gw; r < T; r += nw) {
              const u32x4 a = *(const u32x4*)(oraw + (size_t)r * D_ + 8 * lane), b = *(const u32x4*)(oraw + (size_t)r * D_ + 512 + 8 * lane);
              const u32x4 ga = *(const u32x4*)(P + PI(r, C_HG + 8 * lane)), gb = *(const u32x4*)(P + PI(r, C_RG + 8 * lane));
              float av[8], bv[8]; float sa = 0.f, sb = 0.f;
#pragma unroll
              for (int i = 0; i < 4; ++i) { av[2 * i] = bf2f((bf16_t)(a[i] & 0xffffu)); av[2 * i + 1] = bf2f((bf16_t)(a[i] >> 16)); bv[2 * i] = bf2f((bf16_t)(b[i] & 0xffffu)); bv[2 * i + 1] = bf2f((bf16_t)(b[i] >> 16)); }
#pragma unroll
              for (int i = 0; i < 8; ++i) { sa += av[i] * av[i]; sb += bv[i] * bv[i]; }
              sa = wave_sum(sa); sb += shx<1>(sb); sb += shx<2>(sb); sb += shx<4>(sb); sb += shx<8>(sb);
              const float ra = 1.0f / sqrtf(sa * (1.0f / 512.0f) + 1e-6f), rb = 1.0f / sqrtf(sb * (1.0f / 128.0f) + 1e-6f);
              const f32x4 n0 = ((const f32x4*)(L.hgrn_norm + 8 * lane))[0], n1 = ((const f32x4*)(L.hgrn_norm + 8 * lane))[1];
              u32x4 oa, ob;
#pragma unroll
              for (int i = 0; i < 4; ++i) { const float g0 = bf2f((bf16_t)(ga[i] & 0xffffu)), g1 = bf2f((bf16_t)(ga[i] >> 16)), h0 = bf2f((bf16_t)(gb[i] & 0xffffu)), h1 = bf2f((bf16_t)(gb[i] >> 16));
                  const float w0 = (2 * i < 4) ? n0[2 * i] : n1[2 * i - 4], w1 = (2 * i + 1 < 4) ? n0[2 * i + 1] : n1[2 * i + 1 - 4];
                  oa[i] = pk2bf(av[2 * i] * ra * w0 * g0, av[2 * i + 1] * ra * w1 * g1); ob[i] = pk2bf(bv[2 * i] * rb * h0, bv[2 * i + 1] * rb * h1); }
              *(u32x4*)(OBUF + (size_t)r * 1536 + 8 * lane) = oa; *(u32x4*)(OBUF + (size_t)r * 1536 + 512 + 8 * lane) = ob; } }
#endif
    } break;
    case 7: {
#ifdef EMU
        for (int b = 0; b < 3; ++b) { EpiBranch e{b, P, WSP(float, WS_TMPMIX), WSP(bf16_t, WS_MIXB)}; gemm_bf16(c, OBUF + b * 512, 1536, WSP(bf16_t, WS_WT_BR) + (size_t)b * D_ * 512, T, D_, 512, e); }
#else
        { pg8::Gemm g{OBUF, WSP(bf16_t, WS_WT_BR), T, D_, 512, 1536, 0, 1024, (size_t)D_ * 512 * 2}; pg8::ZOrder<3> S; S.init(T, D_, c.nb, c.bid);
          pg8::EpiAdapt8<EpiBranch8> ea{EpiBranch8{P, WSP(bf16_t, WS_TMPMIX), WSP(bf16_t, WS_MIXB)}};
          pg8::gemm_phase<pg8::EpiAdapt8<EpiBranch8>, pg8::ZOrder<3>, true, true>((PG8_LAS unsigned char*)g_lds, g, S, ea, c.tid); __syncthreads(); }
#endif
    } break;
    case 8: {
#ifdef EMU
        { EpiResidual e{HB, SS + (size_t)(3 * l + 1) * T * SSW}; gemm_bf16(c, WSP(bf16_t, WS_MIXB), D_, WSP(bf16_t, WS_WT_OUT), T, D_, D_, e); }
#else
        { pg8::Gemm g{WSP(bf16_t, WS_MIXB), WSP(bf16_t, WS_WT_OUT), T, D_, D_, D_, 0, 0, 0}; pg8::StaticOrder S; S.init(T, D_, c.nb, c.bid);
          EpiResidualPg8 e{HB, dry ? WSP(bf16_t, WS_XSC) : HB, dry ? nullptr : SS + (size_t)(3 * l + 1) * T * SSW};
          pg8::gemm_phase<EpiResidualPg8, pg8::StaticOrder, true, true>((PG8_LAS unsigned char*)g_lds, g, S, e, c.tid); __syncthreads(); }
#endif
    } break;
    case 9: break;
    case 10: { EpiRowScaleBf16 e{WSP(bf16_t, WS_QX), D_, 0.0625f, SS + (size_t)(3 * l + 1) * T * SSW, WSP(float, WS_RS) + (size_t)(3 * l + 1) * T}; gemm_big_r(c, HB, D_, WSP(bf16_t, WS_WT_XQ), T, D_, D_, e); } break;
    case 11: {
#ifdef EMU
        { EpiStoreF32 e{WSP(float, WS_XSC), D_}; gemm_blockdiag(c, WSP(bf16_t, WS_QX), D_, WSP(bf16_t, WS_KX), T, e); }
#else
        { static_assert((T_ / 256) * 4 == 256, "fused softmax epilogue needs exactly one 256x256 unit per workgroup on a 256-CU grid");
          pg8::Gemm g{WSP(bf16_t, WS_QX), WSP(bf16_t, WS_KX), T, 1024, 256, D_, 512, 0, 0}; pg8::StaticOrder S; S.init(T, 1024, c.nb, c.bid); EpiSoftmaxPg8 e{WSP(bf16_t, WS_PX)};
          if (c.nb == 256) { pg8::gemm_phase<EpiSoftmaxPg8, pg8::StaticOrder, false, true>((PG8_LAS unsigned char*)g_lds, g, S, e, c.tid); __syncthreads(); } }
#endif
    } break;
    case 12: {
        const float* xs = WSP(float, WS_XSC); bf16_t* px = WSP(bf16_t, WS_PX);
#ifdef EMU
        for (long w = c.gtid; w < (long)T * 4; w += c.gsize) { const float* r = xs + w * 256; float mx = -1e30f; for (int i = 0; i < 256; ++i) mx = fmaxf(mx, r[i]);
            float sum = 0.f; for (int i = 0; i < 256; ++i) sum += expf(r[i] - mx); const float inv = 1.0f / sum; for (int i = 0; i < 256; ++i) px[w * 256 + i] = f2bf(expf(r[i] - mx) * inv); }
#else
#endif
    } break;
    case 13: { EpiStoreBf16 e{WSP(bf16_t, WS_OX), D_, 1.0f}; gemm_blockdiag(c, WSP(bf16_t, WS_PX), D_, WSP(bf16_t, WS_VX), T, e); } break;
    case 14: {
#ifdef EMU
        { EpiResidual e{HB, SS + (size_t)(3 * l + 2) * T * SSW}; gemm_bf16(c, WSP(bf16_t, WS_OX), D_, WSP(bf16_t, WS_WT_XO), T, D_, D_, e); }
#else
        { pg8::Gemm g{WSP(bf16_t, WS_OX), WSP(bf16_t, WS_WT_XO), T, D_, D_, D_, 0, 0, 0}; pg8::StaticOrder S; S.init(T, D_, c.nb, c.bid);
          EpiResidualPg8 e{HB, dry ? WSP(bf16_t, WS_XSC) : HB, dry ? nullptr : SS + (size_t)(3 * l + 2) * T * SSW};
          pg8::gemm_phase<EpiResidualPg8, pg8::StaticOrder, true, true>((PG8_LAS unsigned char*)g_lds, g, S, e, c.tid); __syncthreads(); }
#endif
    } break;
    case 15: break;
    case 16: { EpiRowScaleF32 e{WSP(float, WS_PSC), 2048, SS + (size_t)(3 * l + 2) * T * SSW, WSP(float, WS_RS) + (size_t)(3 * l + 2) * T}; gemm_big_r(c, HB, D_, WSP(bf16_t, WS_WT_EFF), T, 2048, D_, e); } break;
    case 17: {
        const float* psc = WSP(float, WS_PSC); int* pidx = WSP(int, WS_PIDX); float* pgate = WSP(float, WS_PGATE);
#ifdef EMU
        for (long w = c.gtid; w < (long)T * 8; w += c.gsize) { const int t = (int)(w >> 3), h = (int)(w & 7);
#else
        static_assert((T_ / 256) * 8 == 2 * 256, "two score tiles per workgroup");
        pg8::StaticOrder SO; SO.init(T, 2048, c.nb, c.bid); pg8::Unit uu;
        for (int it_ = 0; it_ < 1; ++it_) { if (!SO.next(c.tid >> 8, uu)) continue; const int t = uu.pm * 256 + (c.tid & 255), h = uu.pn;
#endif
            unsigned top[2][16];
#pragma unroll
            for (int pp = 0; pp < 2; ++pp) { const float* sr = psc + (size_t)t * 2048 + h * 256 + pp * 128;
#ifndef EMU
                float raw[128]; { const bf16_t* tb = (const bf16_t*)psc + ((size_t)(uu.pm * 8 + uu.pn) << 16) + ((size_t)(pp * 128) << 8) + (c.tid & 255);
#pragma unroll
                for (int i = 0; i < 128; ++i) raw[i] = bf2f(tb[i * 256]); }
#endif
#pragma unroll
                for (int g = 0; g < 8; ++g) { unsigned grp[16];
#pragma unroll
                    for (int i = 0; i < 16; ++i) {
#ifdef EMU
                        const float x = sr[16 * g + i];
#else
                        const float x = raw[16 * g + i];
#endif
                        grp[i] = (fkey(x) & ~127u) | (unsigned)(16 * g + i); }
                    bitonic_sort16_desc(grp);
                    if (g == 0) {
#pragma unroll
                        for (int i = 0; i < 16; ++i) top[pp][i] = grp[i]; }
                    else merge_top16(top[pp], grp); } }
            float v0[16], v1[16];
#pragma unroll
            for (int i = 0; i < 16; ++i) { v0[i] = fkey_inv(top[0][i] & ~127u); v1[i] = fkey_inv(top[1][i] & ~127u); }
            unsigned ck[64];
            cand_fill_a<0>(ck, v0, v1);
#pragma unroll
            for (int i = 50; i < 64; ++i) ck[i] = 0u;
            unsigned ct[16], cg[16];
#pragma unroll
            for (int i = 0; i < 16; ++i) ct[i] = ck[i];
            bitonic_sort16_desc(ct);
#pragma unroll
            for (int g = 1; g < 4; ++g) {
#pragma unroll
                for (int i = 0; i < 16; ++i) cg[i] = ck[16 * g + i];
                bitonic_sort16_desc(cg); merge_top16(ct, cg); }
#ifdef EMU
            unsigned char tab[32];
#else
            unsigned char* tab = g_lds + c.tid * 32;
#endif
#pragma unroll
            for (int i = 0; i < 16; ++i) { tab[i] = (unsigned char)(top[0][i] & 127u); tab[16 + i] = (unsigned char)(top[1][i] & 127u); }
            float ev[16], sum = 0.f; const float cmax = fkey_inv(ct[0] & ~255u);
#pragma unroll
            for (int j = 0; j < 16; ++j) { ev[j] = expf(fkey_inv(ct[j] & ~255u) - cmax); sum += ev[j]; }
            const float inv = 1.0f / sum;
#pragma unroll
            for (int j = 0; j < 16; ++j) { const unsigned code = ct[j] & 255u; pidx[(size_t)t * 128 + h * 16 + j] = (int)tab[code >> 4] * 128 + (int)tab[16 + (code & 15u)]; pgate[(size_t)t * 128 + h * 16 + j] = ev[j] * inv; }
        }
#ifndef EMU
        __syncthreads();
#endif
    } break;
    case 18: {
        const int* pidx = WSP(int, WS_PIDX); const float* pgate = WSP(float, WS_PGATE); const unsigned char* tu = WSP(unsigned char, WS_TABU);
#ifdef EMU
        float* coef = WSP(float, WS_COEF);
        for (long w = c.gtid; w < (long)T * 128; w += c.gsize) { const int t = (int)(w >> 7); const unsigned char* ur = tu + (size_t)pidx[w] * PEER_ROWB; const bf16_t* hr = HB + (size_t)t * D_; float sacc = 0.f;
            for (int d = 0; d < D_; ++d) sacc += bf2f(hr[d]) * tab_get_sw(ur, d);
            coef[w] = pgate[w] * geluf_(sacc * row_rstd(SS + (size_t)(3 * l + 2) * T * SSW, t) * (1.0f / PEER_U_SCALE)) * (1.0f / PEER_V_SCALE); }
#else
        {
          const unsigned char* tv = WSP(unsigned char, WS_TABV); const int lane = c.tid & 63, wv = c.tid >> 6, gw = c.gtid >> 6, nw = c.gsize >> 6;
          typedef float f32x2 __attribute__((ext_vector_type(2))); typedef int i32x8 __attribute__((ext_vector_type(8)));
          float* lcoef = (float*)g_lds + wv * 128; unsigned char* wx = g_lds + 8192 + wv * 2048;
          const float* ssn = SS + (size_t)(3 * l + 2) * T * SSW;
          const int c16 = lane & 15; const unsigned g16 = (unsigned)(lane >> 4) * 16u, lane8 = (unsigned)lane * 8u;
#define PEER_TOKLOAD(t, i0, i1, g0, g1, a, b, r) { const unsigned o = (unsigned)(t) * 128u + (unsigned)lane; i0 = pidx[o]; i1 = pidx[o + 64]; g0 = pgate[o]; g1 = pgate[o + 64]; \
              const u32x4* xr = (const u32x4*)(HB + (size_t)(t) * D_ + lane * 16); a = xr[0]; b = xr[1]; r = row_rstd(ssn, (t)); }
#define PEER_VLOAD(vl, j0) { const int isel = ((j0) < 64) ? idx0 : idx1; _Pragma("unroll") for (int b2 = 0; b2 < 8; ++b2) { const int e = __builtin_amdgcn_readlane(isel, (((j0) & 63) + b2)); vl[b2] = *(const unsigned long long*)((tv + (unsigned)e * PEER_ROWB) + lane8); } }
#define PEER_VPROC(vl, j0) _Pragma("unroll") for (int b2 = 0; b2 < 8; ++b2) { const float cj = lcoef[(j0) + b2]; \
                  _Pragma("unroll") for (int w2 = 0; w2 < 2; ++w2) { const unsigned wd = (unsigned)(vl[b2] >> (32 * w2)); \
                      const f32x2 p0 = __builtin_amdgcn_cvt_scalef32_pk_f32_fp4(wd, 1.0f, 0), p1 = __builtin_amdgcn_cvt_scalef32_pk_f32_fp4(wd, 1.0f, 1), p2 = __builtin_amdgcn_cvt_scalef32_pk_f32_fp4(wd, 1.0f, 2), p3 = __builtin_amdgcn_cvt_scalef32_pk_f32_fp4(wd, 1.0f, 3); \
                      oacc[8 * w2] += cj * p0[0]; oacc[8 * w2 + 1] += cj * p0[1]; oacc[8 * w2 + 2] += cj * p1[0]; oacc[8 * w2 + 3] += cj * p1[1]; \
                      oacc[8 * w2 + 4] += cj * p2[0]; oacc[8 * w2 + 5] += cj * p2[1]; oacc[8 * w2 + 6] += cj * p3[0]; oacc[8 * w2 + 7] += cj * p3[1]; } \
                  asm volatile("" : "+v"(oacc[0]), "+v"(oacc[1]), "+v"(oacc[2]), "+v"(oacc[3]), "+v"(oacc[4]), "+v"(oacc[5]), "+v"(oacc[6]), "+v"(oacc[7]), "+v"(oacc[8]), "+v"(oacc[9]), "+v"(oacc[10]), "+v"(oacc[11]), "+v"(oacc[12]), "+v"(oacc[13]), "+v"(oacc[14]), "+v"(oacc[15])); }
#define PEER_BLOAD(bf, eg) { const int e = ((eg) < 4) ? bperm_i(idx0, (eg) * 16 + c16) : bperm_i(idx1, ((eg) - 4) * 16 + c16); const unsigned char* bp = tu + ((unsigned)e * PEER_ROWB + g16); \
                  _Pragma("unroll") for (int kk = 0; kk < 8; ++kk) bf[kk] = *(const u32x4*)(bp + kk * 64); }
#define PEER_BPROC(bf, eg) { f32x4 dacc = (f32x4){0.f, 0.f, 0.f, 0.f}; \
                  _Pragma("unroll") for (int kk = 0; kk < 8; ++kk) { const i32x8 bb = (i32x8){(int)bf[kk][0], (int)bf[kk][1], (int)bf[kk][2], (int)bf[kk][3], 0, 0, 0, 0}; \
                      dacc = __builtin_amdgcn_mfma_scale_f32_16x16x128_f8f6f4(afr[kk], bb, dacc, 0, 4, 0, 0x7f7f7f7f, 0, 0x7f7f7f7f); } \
                  lcoef[(lane < 16) ? (eg) * 16 + lane : 1024 + wv * 64 + lane - wv * 128] = dacc[0] + dacc[1] * 0.0625f; }
#define SB __builtin_amdgcn_sched_barrier(0);
          int tok = gw; int idx0 = 0, idx1 = 0; float gt0 = 0.f, gt1 = 0.f, rs = 0.f; u32x4 xa = (u32x4){0u, 0u, 0u, 0u}, xc = xa;
          if (tok < T) { PEER_TOKLOAD(tok, idx0, idx1, gt0, gt1, xa, xc, rs) }
          for (; tok < T; tok += nw) {
              unsigned long long vlA[8], vlB[8], vlC[8], vlD[8];
              PEER_VLOAD(vlA, 0) PEER_VLOAD(vlB, 8) PEER_VLOAD(vlC, 16) SB
              { u32x4 hi4, lo4;
#pragma unroll
                for (int i = 0; i < 4; ++i) { const unsigned w0 = (i < 2) ? xa[2 * (i & 1)] : xc[2 * (i & 1)], w1 = (i < 2) ? xa[2 * (i & 1) + 1] : xc[2 * (i & 1) + 1];
                    const float f0 = bf2f((bf16_t)(w0 & 0xffffu)) * rs, f1 = __uint_as_float(w0 & 0xffff0000u) * rs, f2 = bf2f((bf16_t)(w1 & 0xffffu)) * rs, f3 = __uint_as_float(w1 & 0xffff0000u) * rs;
                    int h = 0; h = __builtin_amdgcn_cvt_pk_fp8_f32(f0, f1, h, false); h = __builtin_amdgcn_cvt_pk_fp8_f32(f2, f3, h, true);
                    const f32x2 b01 = __builtin_amdgcn_cvt_pk_f32_fp8(h, false), b23 = __builtin_amdgcn_cvt_pk_f32_fp8(h, true);
                    int lo = 0; lo = __builtin_amdgcn_cvt_pk_fp8_f32((f0 - b01[0]) * 16.0f, (f1 - b01[1]) * 16.0f, lo, false); lo = __builtin_amdgcn_cvt_pk_fp8_f32((f2 - b23[0]) * 16.0f, (f3 - b23[1]) * 16.0f, lo, true);
                    hi4[i] = (unsigned)h; lo4[i] = (unsigned)lo; }
                *(u32x4*)(wx + lane * 16) = hi4; *(u32x4*)(wx + 1024 + lane * 16) = lo4; }
              i32x8 afr[8];
              { const unsigned char* ar = wx + (lane & 1) * 1024 + (lane >> 4) * 16;
#pragma unroll
                for (int kk = 0; kk < 8; ++kk) { const u32x4 a0 = *(const u32x4*)(ar + kk * 128), a1 = *(const u32x4*)(ar + kk * 128 + 64);
                    afr[kk] = (i32x8){(int)a0[0], (int)a0[1], (int)a0[2], (int)a0[3], (int)a1[0], (int)a1[1], (int)a1[2], (int)a1[3]}; } }
              u32x4 bfA[8], bfB[8];
              PEER_BLOAD(bfA, 0)
#pragma unroll 1
              for (int eg = 0; eg < 8; eg += 2) {
                  PEER_BLOAD(bfB, eg + 1)
                  PEER_BPROC(bfA, eg)
                  if (eg + 2 < 8) { PEER_BLOAD(bfA, eg + 2) }
                  PEER_BPROC(bfB, eg + 1)
              }
              { const float d0 = lcoef[lane], d1 = lcoef[64 + lane];
                const float c0 = gt0 * geluf_(d0 * (1.0f / PEER_U_SCALE)) * (1.0f / PEER_V_SCALE), c1 = gt1 * geluf_(d1 * (1.0f / PEER_U_SCALE)) * (1.0f / PEER_V_SCALE);
                lcoef[lane] = c0; lcoef[64 + lane] = c1; }
              int nidx0, nidx1; float ngt0, ngt1, nrs; u32x4 nxa, nxc;
              { const int ntok = (tok + nw < T) ? tok + nw : tok; PEER_TOKLOAD(ntok, nidx0, nidx1, ngt0, ngt1, nxa, nxc, nrs) }
              float oacc[16];
#pragma unroll
              for (int i = 0; i < 16; ++i) oacc[i] = 0.f;
              SB
#pragma unroll 1
              for (int j0 = 0; j0 < 96; j0 += 32) {
                  PEER_VLOAD(vlD, j0 + 24) SB
                  PEER_VPROC(vlA, j0) SB
                  PEER_VLOAD(vlA, j0 + 32) SB
                  PEER_VPROC(vlB, j0 + 8) SB
                  PEER_VLOAD(vlB, j0 + 40) SB
                  PEER_VPROC(vlC, j0 + 16) SB
                  PEER_VLOAD(vlC, j0 + 48) SB
                  PEER_VPROC(vlD, j0 + 24) SB
              }
              PEER_VLOAD(vlD, 120) SB
              PEER_VPROC(vlA, 96) SB
              PEER_VPROC(vlB, 104) SB
              PEER_VPROC(vlC, 112) SB
              PEER_VPROC(vlD, 120) SB
              f32x4 xo[4]; float q = 0.f;
#pragma unroll
              for (int k = 0; k < 4; ++k) { const u32x4 xs = (k < 2) ? xa : xc; const int b0 = 2 * (k & 1);
                  xo[k] = (f32x4){bf2f((bf16_t)(xs[b0] & 0xffffu)), __uint_as_float(xs[b0] & 0xffff0000u), bf2f((bf16_t)(xs[b0 + 1] & 0xffffu)), __uint_as_float(xs[b0 + 1] & 0xffff0000u)} + (f32x4){oacc[4 * k], oacc[4 * k + 1], oacc[4 * k + 2], oacc[4 * k + 3]}; }
              if (dry) { u32x4* xb = (u32x4*)(WSP(bf16_t, WS_XSC) + (size_t)tok * D_ + lane * 16); xb[0] = (u32x4){pk2bf(xo[0][0], xo[0][1]), pk2bf(xo[0][2], xo[0][3]), pk2bf(xo[1][0], xo[1][1]), pk2bf(xo[1][2], xo[1][3])}; }
              else if (l < DEPTH - 1) {
                  u32x4 w0 = (u32x4){pk2bf(xo[0][0], xo[0][1]), pk2bf(xo[0][2], xo[0][3]), pk2bf(xo[1][0], xo[1][1]), pk2bf(xo[1][2], xo[1][3])}, w1 = (u32x4){pk2bf(xo[2][0], xo[2][1]), pk2bf(xo[2][2], xo[2][3]), pk2bf(xo[3][0], xo[3][1]), pk2bf(xo[3][2], xo[3][3])};
                  u32x4* xb = (u32x4*)(HB + (size_t)tok * D_ + lane * 16); xb[0] = w0; xb[1] = w1;
#pragma unroll
                  for (int i = 0; i < 4; ++i) { const float a0 = bf2f((bf16_t)(w0[i] & 0xffffu)), a1 = __uint_as_float(w0[i] & 0xffff0000u), c0 = bf2f((bf16_t)(w1[i] & 0xffffu)), c1 = __uint_as_float(w1[i] & 0xffff0000u); q += (a0 * a0 + a1 * a1) + (c0 * c0 + c1 * c1); }
                  q = wave_sum(q);
                  if (lane < 4) ((f32x4*)(SS + ((size_t)(3 * (l + 1)) * T + tok) * SSW))[lane] = (f32x4){lane == 0 ? q : 0.f, 0.f, 0.f, 0.f}; }
              else {
#pragma unroll
                  for (int k = 0; k < 4; ++k) q += (xo[k][0] * xo[k][0] + xo[k][1] * xo[k][1]) + (xo[k][2] * xo[k][2] + xo[k][3] * xo[k][3]);
                  q = wave_sum(q);
                  const float rsf = rstd_from_ss(q); const f32x4* gf = (const f32x4*)(p.in[23] + lane * 16); f32x4* wp = (f32x4*)(p.out + (size_t)tok * D_ + lane * 16);
#pragma unroll
                  for (int k = 0; k < 4; ++k) wp[k] = xo[k] * rsf * gf[k]; }
              idx0 = nidx0; idx1 = nidx1; gt0 = ngt0; gt1 = ngt1; rs = nrs; xa = nxa; xc = nxc;
          }
#undef SB
#undef PEER_TOKLOAD
#undef PEER_VLOAD
#undef PEER_VPROC
#undef PEER_BLOAD
#undef PEER_BPROC
          __syncthreads(); }
#endif
    } break;
    case 19: {
#ifdef EMU
        const int* pidx = WSP(int, WS_PIDX); const float* coef = WSP(float, WS_COEF); const unsigned char* tv = WSP(unsigned char, WS_TABV);
        for (int t = c.gtid; t < T; t += c.gsize) { float q = 0.f; bf16_t* xb = HB + (size_t)t * D_; float* xr = p.out + (size_t)t * D_;
            for (int d = 0; d < D_; ++d) { float sacc = 0.f; for (int j = 0; j < 128; ++j) sacc += coef[(size_t)t * 128 + j] * tab_get_sw(tv + (size_t)pidx[(size_t)t * 128 + j] * PEER_ROWB, d); xr[d] = bf2f(xb[d]) + sacc; }
            if (l < DEPTH - 1) { for (int d = 0; d < D_; ++d) { xb[d] = f2bf(xr[d]); const float x = bf2f(xb[d]); q += x * x; } SS[((size_t)(3 * (l + 1)) * T + t) * SSW] = q; }
            else { for (int d = 0; d < D_; ++d) q += xr[d] * xr[d]; const float rs = rstd_from_ss(q); for (int d = 0; d < D_; ++d) xr[d] = xr[d] * rs * p.in[23][d]; } }
#endif
    } break;
    }
}

DEV void run_stage(const Params& p, int stage) {
    if (stage == DEPTH * N_STAGES_PER_LAYER) return;
    run_stage_ls(p, stage / N_STAGES_PER_LAYER, stage % N_STAGES_PER_LAYER);
}
#ifndef EMU
#if N_LAUNCH_MODE == 0
__global__ void __launch_bounds__(NTHREADS) k_stage(Params p, int stage) { run_stage(p, stage); }
#endif
#if N_LAUNCH_MODE == 1
#define XB_TMO      128
#define XB_XCNT(j)  (256  + 64 * (j))
#define XB_XSUB(j)  (1280 + 64 * (j))
#define XB_XGEN(j)  (2304 + 64 * (j))
#define XB_TOP      3328
#define XB_TOPGEN   3392
#define XCD_BAR_WORDS 3456
#define XB_SPIN_CAP (1u << 18)
#define XLAS __attribute__((address_space(3)))

__device__ __forceinline__ unsigned xb_ld(unsigned* p)              { return __hip_atomic_load(p, __ATOMIC_RELAXED, __HIP_MEMORY_SCOPE_AGENT); }
__device__ __forceinline__ unsigned xb_add(unsigned* p, unsigned v) { return __hip_atomic_fetch_add(p, v, __ATOMIC_RELAXED, __HIP_MEMORY_SCOPE_AGENT); }
__device__ __forceinline__ unsigned xb_xcc_id() { return (unsigned)__builtin_amdgcn_s_getreg((3 << 11) | 20) & 0xFu; }
#define XB_SPIN(cond, bar) do { unsigned _sp = 0; while (cond) { __builtin_amdgcn_s_sleep(1); \
    if ((++_sp & 255u) == 0u) { if (xb_ld(&(bar)[XB_TMO])) break; if (_sp > XB_SPIN_CAP) { atomicAdd(&(bar)[XB_TMO], 1u); break; } } } } while (0)

struct XcdBarrier {
    unsigned* bar; unsigned x;
    volatile XLAS unsigned* st;
};

__device__ __forceinline__ XcdBarrier xcd_barrier_post(unsigned* bar, volatile XLAS unsigned* st) {
    XcdBarrier b; b.bar = bar; b.x = xb_xcc_id(); b.st = st;
    if (threadIdx.x == 0) (void)xb_add(&bar[XB_XCNT(b.x)], 1u);
    return b;
}
__device__ __forceinline__ void xcd_barrier_complete(unsigned* bar, unsigned x, unsigned& nloc, unsigned& nx) {
    const unsigned G = gridDim.x * gridDim.y * gridDim.z;
    unsigned sum, cnt, mine, sp = 0u;
    for (;;) {
        sum = 0u; cnt = 0u; mine = 0u;
#pragma unroll
        for (unsigned j = 0; j < 16; ++j) { const unsigned c = xb_ld(&bar[XB_XCNT(j)]); sum += c; cnt += (c > 0u) ? 1u : 0u; mine = (j == x) ? c : mine; }
        if (sum == G) break;
        __builtin_amdgcn_s_sleep(1);
        if ((++sp & 255u) == 0u) { if (xb_ld(&bar[XB_TMO])) break; if (sp > XB_SPIN_CAP) { atomicAdd(&bar[XB_TMO], 1u); break; } }
    }
    nloc = mine > 0u ? mine : 1u; nx = cnt > 0u ? cnt : 1u;
}

__device__ __forceinline__ void xcd_barrier(const XcdBarrier& b) {
    asm volatile("s_waitcnt vmcnt(0)" ::: "memory");
    __syncthreads();
    if (threadIdx.x == 0) {
        unsigned* bar = b.bar;
        __builtin_amdgcn_s_waitcnt(0);
        unsigned nloc = b.st[0], nx = b.st[1];
        if (nloc == 0u) { xcd_barrier_complete(bar, b.x, nloc, nx); b.st[0] = nloc; b.st[1] = nx; }
        const unsigned old = xb_add(&bar[XB_XSUB(b.x)], 1u);
        const unsigned gen = old / nloc;
        if (old + 1u == (gen + 1u) * nloc) {
            __builtin_amdgcn_fence(__ATOMIC_RELEASE, "agent");
            asm volatile("s_waitcnt vmcnt(0)" ::: "memory");
            const unsigned og = xb_add(&bar[XB_TOP], 1u);
            const unsigned tg = og / nx;
            if (og + 1u == (tg + 1u) * nx) xb_add(&bar[XB_TOPGEN], 1u);
            else XB_SPIN(xb_ld(&bar[XB_TOPGEN]) == tg, bar);
            __builtin_amdgcn_fence(__ATOMIC_ACQUIRE, "agent");
            xb_add(&bar[XB_XGEN(b.x)], 1u);
            asm volatile("s_waitcnt vmcnt(0)" ::: "memory");
        } else {
            XB_SPIN(xb_ld(&bar[XB_XGEN(b.x)]) == gen, bar);
            __builtin_amdgcn_fence(__ATOMIC_ACQUIRE, "agent");
            asm volatile("s_waitcnt vmcnt(0)" ::: "memory");
        }
    }
    __syncthreads();
}


typedef const unsigned long long __attribute__((address_space(4))) * kargp_t;
DEV void load_params(Params& q) { kargp_t kp = (kargp_t)__builtin_amdgcn_kernarg_segment_ptr(); asm volatile("" : "+s"(kp));
#pragma unroll
    for (int i = 0; i < 24; ++i) q.in[i] = (const float*)(const float __attribute__((address_space(1)))*)kp[i];
    q.out = (float*)(float __attribute__((address_space(1)))*)kp[24]; q.ws = (unsigned char*)(unsigned char __attribute__((address_space(1)))*)kp[25]; q.T = T_; q.pad = 0; }
__global__ void __launch_bounds__(NTHREADS) k_mega(Params p) {
    cg::grid_group grid = cg::this_grid();
    volatile XLAS unsigned* xst = (volatile XLAS unsigned*)(XLAS unsigned char*)(g_lds + 131072 + 64);
    if (threadIdx.x < 4) xst[threadIdx.x] = 0u;
    __syncthreads();
    const int wave_u = __builtin_amdgcn_readfirstlane(threadIdx.x >> 6);
    const XcdBarrier xbar = xcd_barrier_post((unsigned*)(p.ws + WS_CTL), xst);
    if (p.T < 0) grid.sync();
#define RS(k) if (DUPMASK & (1 << (k))) { { Params q; load_params(q); run_stage_ls(q, l, k, true, wave_u); } xcd_barrier(xbar); } { Params q; load_params(q); run_stage_ls(q, l, k, false, wave_u); } xcd_barrier(xbar);
#define RSL(k) { Params q; load_params(q); run_stage_ls(q, l, k, false, wave_u); } asm volatile("s_waitcnt vmcnt(0)" ::: "memory"); __syncthreads();
#pragma unroll 1
    for (int l = 0; l < DEPTH; ++l) { RS(0) RS(1) RS(2) RS(3) RS(4) RS(5) RS(6) RS(7) RS(8) RSL(10) RSL(11) RS(13) RS(14) RSL(16) RS(17) RS(18) }
#undef RS
#undef RSL
}
#define K_MAIN k_mega
#else
#define K_MAIN k_stage
#endif

extern "C" void kernel_launch(void* const* d_in, const int* in_sizes, int n_in, void* d_out, int out_size, void* d_ws, size_t ws_size, hipStream_t stream) {
    static int grid = 0;
    if (grid == 0) {
        if (n_in != 24 || out_size != T_ * D_ || ws_size < WS_END) { fprintf(stderr, "kernel_launch: unexpected shapes n_in %d out %d ws %zu\n", n_in, out_size, ws_size); grid = -1; return; }
        int dev = 0, cus = 0, per_cu = 0; hipGetDevice(&dev); hipDeviceGetAttribute(&cus, hipDeviceAttributeMultiprocessorCount, dev);
        if (hipFuncSetAttribute((const void*)K_MAIN, hipFuncAttributeMaxDynamicSharedMemorySize, LDS_BYTES) != hipSuccess) { fprintf(stderr, "hipFuncSetAttribute failed\n"); grid = -1; return; }
        hipOccupancyMaxActiveBlocksPerMultiprocessor(&per_cu, (const void*)K_MAIN, NTHREADS, LDS_BYTES);
        if (per_cu < 1) per_cu = 1;
        grid = cus * (per_cu > 1 ? 1 : 1);
    }
    if (grid < 0) return;
    hipMemsetAsync((char*)d_ws + WS_CTL, 0, 65536, stream);
    Params p{}; for (int i = 0; i < 24; ++i) p.in[i] = (const float*)d_in[i];
    p.out = (float*)d_out; p.ws = (unsigned char*)d_ws; p.T = T_; p.pad = 0;
#if N_LAUNCH_MODE == 1
    void* args[] = {&p};
    hipError_t e = hipLaunchCooperativeKernel((const void*)k_mega, dim3(grid), dim3(NTHREADS), args, LDS_BYTES, stream);
    if (e != hipSuccess) fprintf(stderr, "cooperative launch failed: %s (grid %d)\n", hipGetErrorString(e), grid);
#else
    for (int s = 0; s < N_STAGES; ++s) hipLaunchKernelGGL(k_stage, dim3(grid), dim3(NTHREADS), LDS_BYTES, stream, p, s);
#endif
}
#endif
```

```cpp
#ifndef EMU
#include <hip/hip_runtime.h>
#include <hip/hip_cooperative_groups.h>
#include <cstdio>
#include <cstdint>
namespace cg = cooperative_groups;
#endif

#ifndef SEQ_T
#define SEQ_T 16384
#endif
#ifndef N_LAUNCH_MODE
#define N_LAUNCH_MODE 1
#endif
#ifndef DUPMASK
#define DUPMASK 0
#endif
#define DEV __device__ __forceinline__

typedef unsigned short bf16_t;
constexpr int T_ = SEQ_T, D_ = 1024, NIN = 7936, DEPTH = 2, NMEM = 256;
constexpr int NTHREADS = 512;
constexpr int C_HQ = 0, C_HF = 512, C_HI = 1024, C_HG = 1536, C_RQ = 2048, C_RK = 2560, C_RV = 3072, C_RG = 3584, C_SQ = 4096, C_SK = 4608, C_SV = 4736, C_GT = 4864;

DEV float bf2f(bf16_t h) { return __uint_as_float(((unsigned)h) << 16); }
DEV bf16_t f2bf(float f) { unsigned u = __float_as_uint(f); return (bf16_t)((u + 0x7fffu + ((u >> 16) & 1u)) >> 16); }
DEV float sigmoidf_(float x) { return 1.0f / (1.0f + expf(-x)); }
DEV float siluf_(float x) { return x / (1.0f + expf(-x)); }
DEV float geluf_(float x) { return 0.5f * x * (1.0f + erff(x * 0.70710678118654752f)); }


#ifndef PEER_FP4
#define PEER_MFMA 1
#define PEER_FP4 1
#endif
#if PEER_FP4
constexpr float PEER_U_SCALE = 64.0f, PEER_V_SCALE = 5.656854249f;
constexpr int PEER_ROWB = 512;
#else
constexpr float PEER_U_SCALE = 32.0f, PEER_V_SCALE = 4.0f;
constexpr int PEER_ROWB = 1024;
#endif
#ifdef EMU
DEV unsigned char f2fp8_sw(float f) { const unsigned s = (f < 0.f) ? 0x80u : 0u; float a = fabsf(f); if (!(a == a)) return 0x7f; if (a >= 448.f) return (unsigned char)(s | 0x7e);
    if (a < 0.0009765625f) return (unsigned char)s; int e = (int)floorf(log2f(a)); if (e < -6) { const int q = (int)rintf(a * 512.0f); return (unsigned char)(s | (unsigned)q); }
    float m = a / exp2f((float)e); int q = (int)rintf((m - 1.0f) * 8.0f); if (q == 8) { q = 0; ++e; } unsigned code = ((unsigned)(e + 7) << 3) | (unsigned)q; if (code > 0x7e) code = 0x7e; return (unsigned char)(s | code); }
DEV float fp82f_sw(unsigned char c);
DEV unsigned char f2fp4_sw(float f) { const float g[8] = {0.f, 0.5f, 1.f, 1.5f, 2.f, 3.f, 4.f, 6.f}; const float a = fabsf(f); int best = 0; float bd = 1e30f;
    for (int i = 0; i < 8; ++i) { const float d = fabsf(a - g[i]); if (d < bd || (d == bd && (i & 1) == 0)) { bd = d; best = i; } } return (unsigned char)(best | (f < 0.f ? 8 : 0)); }
DEV float fp42f_sw(unsigned char c) { const float g[8] = {0.f, 0.5f, 1.f, 1.5f, 2.f, 3.f, 4.f, 6.f}; return (c & 8) ? -g[c & 7] : g[c & 7]; }
DEV float tab_get_sw(const unsigned char* row, int d) {
#if PEER_FP4
    return fp42f_sw((unsigned char)((row[d >> 1] >> ((d & 1) * 4)) & 15));
#else
    return fp82f_sw(row[d]);
#endif
}
DEV float fp82f_sw(unsigned char c) { const float sg = (c & 0x80) ? -1.f : 1.f; const int e = (c >> 3) & 15, m = c & 7; return sg * (e == 0 ? (float)m * 0.001953125f : (1.0f + (float)m * 0.125f) * exp2f((float)(e - 7))); }
#endif
constexpr size_t MiB = 1u << 20;
constexpr size_t WS_CTL = 0;
constexpr size_t WS_SS = 500 * MiB;
constexpr size_t WS_LB = 512 * 1024;
constexpr size_t WS_WT_IN = 1 * MiB;
constexpr size_t WS_WT_BR = 17 * MiB;
constexpr size_t WS_WT_OUT = 20 * MiB, WS_WT_XQ = 22 * MiB, WS_WT_XK = 24 * MiB, WS_WT_XV = 26 * MiB, WS_WT_XO = 28 * MiB;
constexpr size_t WS_WT_EFF = 30 * MiB;
constexpr size_t WS_HM = 34 * MiB, WS_KX = 34 * MiB + 512 * 1024, WS_VX = 35 * MiB;
constexpr size_t WS_TABU = 348 * MiB, WS_TABV = 364 * MiB;
constexpr size_t WS_ORAW = 36 * MiB;
constexpr size_t WS_TMPMIX = 36 * MiB;
constexpr size_t WS_P = 100 * MiB;
constexpr size_t WS_LOGF = 348 * MiB;
constexpr size_t WS_OBUF = 380 * MiB;
constexpr size_t WS_HB = 428 * MiB;
constexpr size_t WS_MIXB = 460 * MiB;
constexpr size_t WS_QX = 100 * MiB, WS_OX = 132 * MiB;
constexpr size_t WS_XSC = 164 * MiB;
constexpr size_t WS_PSC = 100 * MiB;
constexpr size_t WS_PX = 228 * MiB;
constexpr size_t WS_PIDX = 228 * MiB, WS_PGATE = 236 * MiB, WS_COEF = 244 * MiB;
constexpr size_t WS_KT = 428 * MiB;
constexpr size_t WS_VT = 460 * MiB;
constexpr size_t WS_LS = 36 * MiB;
constexpr size_t WS_ORAWB = 428 * MiB;
constexpr size_t WS_VEC = 492 * MiB;
constexpr size_t WS_SVT = 496 * MiB;
constexpr size_t WS_RS = 507 * MiB;
constexpr size_t WS_END = 508 * MiB;

constexpr int PB_COLS = 4096;
DEV size_t PI(int row, int col) { return col < PB_COLS ? ((((size_t)(row >> 6) * 32 + (size_t)(col >> 7)) << 13) + (size_t)((row & 63) << 7) + (size_t)(col & 127)) : ((size_t)T_ * PB_COLS + (size_t)row * (NIN - PB_COLS) + (size_t)(col - PB_COLS)); }
struct Params { const float* in[24]; float* out; unsigned char* ws; int T; int pad; };

struct Ctx { int gtid, gsize, bid, nb, tid; };
#ifndef EMU
DEV int lane_id_fresh() { int l; asm volatile("v_mbcnt_lo_u32_b32 %0, -1, 0\n\tv_mbcnt_hi_u32_b32 %0, -1, %0" : "=v"(l)); return l; }
#endif
DEV Ctx make_ctx(int wave_u = -1) { Ctx c; int tid = threadIdx.x, bid = blockIdx.x;
#ifndef EMU
    if (wave_u >= 0) tid = wave_u * 64 + lane_id_fresh();
    asm volatile("" : "+v"(tid)); asm volatile("" : "+s"(bid));
#endif
    c.tid = tid; c.bid = bid; c.nb = gridDim.x; c.gtid = bid * (int)blockDim.x + tid; c.gsize = gridDim.x * blockDim.x; return c; }

template <int MAPMODE>
DEV void cvt_transpose(const Ctx& c, const float* src, int ldn, int coff, int K, int N, bf16_t* dst, const float* gain = nullptr) {
    const long total = (long)N * K;
    for (long i = c.gtid; i < total; i += c.gsize) {
        const int n = (int)(i / K), k = (int)(i % K);
        int sn = n;
        if (MAPMODE == 1) { const int hd = n & ~127, j = n & 127; sn = hd + ((j & 1) ? 64 + (j >> 1) : (j >> 1)); }
        if (MAPMODE == 2) { const int hd = n & ~63, j = n & 63; sn = hd + ((j & 1) ? 32 + (j >> 1) : (j >> 1)); }
        dst[i] = f2bf(src[(size_t)k * ldn + coff + sn] * (gain ? gain[k] : 1.0f));
    }
}

DEV void rmsnorm_rows_bf16(const Ctx& c, const float* x, const float* g, bf16_t* dst, int rows);
#ifndef EMU
typedef short bf16x8 __attribute__((ext_vector_type(8)));
typedef float f32x4 __attribute__((ext_vector_type(4)));
typedef unsigned u32x4 __attribute__((ext_vector_type(4)));
extern __shared__ __attribute__((aligned(16))) unsigned char g_lds[];
constexpr int G_BM = 128, G_BN = 128, G_BK = 32, G_LDS_STRIDE = 80;
constexpr int LDS_BYTES = 131072 + 1024;
#endif

template <class E> struct EpiNoBatch { const E& e; DEV void operator()(int, int r, int c, const float* v) const { e(r, c, v); } };
template <class E>
DEV void gemm_bf16_batched(const Ctx& c, const bf16_t* A0, int lda, const bf16_t* Wt0, int M, int N, int K, int nbatch, size_t strideA, size_t strideW, const E& e) {
#ifdef EMU
    for (long w = c.gtid; w < (long)nbatch * M; w += c.gsize) { const int bt = (int)(w / M), m = (int)(w % M); const bf16_t* A = A0 + bt * strideA; const bf16_t* Wt = Wt0 + bt * strideW;
        for (int n = 0; n < N; n += 4) {
            float v[4] = {0.f, 0.f, 0.f, 0.f};
            for (int j = 0; j < 4; ++j) { float s = 0.f; for (int k = 0; k < K; ++k) s += bf2f(A[(size_t)m * lda + k]) * bf2f(Wt[(size_t)(n + j) * K + k]); v[j] = s; }
            e(bt, m, n, v);
        } }
#else
    unsigned char* As = g_lds; unsigned char* Bs = g_lds + 128 * G_LDS_STRIDE;
    const int tid = c.tid, wid = tid >> 6, lane = tid & 63, wm = wid >> 2, wn = wid & 3, fr = lane & 15, fq = lane >> 4;
    const int ntm = M / G_BM, ntn = N / G_BN, ntiles1 = ntm * ntn, ntiles = ntiles1 * nbatch;
    const int lrow = tid >> 2, lkc = tid & 3;
    for (int tile0 = c.bid; tile0 < ntiles; tile0 += c.nb) {
        const int bt = tile0 / ntiles1, tile = tile0 % ntiles1; const bf16_t* A = A0 + bt * strideA; const bf16_t* Wt = Wt0 + bt * strideW;
        const int tm = tile % ntm, tn = tile / ntm, m0 = tm * G_BM, n0 = tn * G_BN;
        f32x4 acc[4][2];
#pragma unroll
        for (int i = 0; i < 4; ++i)
#pragma unroll
            for (int j = 0; j < 2; ++j) acc[i][j] = (f32x4){0.f, 0.f, 0.f, 0.f};
        const bf16_t* ap = A + (size_t)(m0 + lrow) * lda + lkc * 8;
        const bf16_t* bp = Wt + (size_t)(n0 + lrow) * K + lkc * 8;
        for (int k0 = 0; k0 < K; k0 += G_BK) {
            const u32x4 av = *(const u32x4*)(ap + k0), bv = *(const u32x4*)(bp + k0);
            __syncthreads();
            *(u32x4*)(As + lrow * G_LDS_STRIDE + lkc * 16) = av;
            *(u32x4*)(Bs + lrow * G_LDS_STRIDE + lkc * 16) = bv;
            __syncthreads();
            bf16x8 af[4], bfg[2];
#pragma unroll
            for (int i = 0; i < 4; ++i) af[i] = *(const bf16x8*)(As + (wm * 64 + i * 16 + fr) * G_LDS_STRIDE + fq * 16);
#pragma unroll
            for (int j = 0; j < 2; ++j) bfg[j] = *(const bf16x8*)(Bs + (wn * 32 + j * 16 + fr) * G_LDS_STRIDE + fq * 16);
#pragma unroll
            for (int i = 0; i < 4; ++i)
#pragma unroll
                for (int j = 0; j < 2; ++j) acc[i][j] = __builtin_amdgcn_mfma_f32_16x16x32_bf16(bfg[j], af[i], acc[i][j], 0, 0, 0);
        }
#pragma unroll
        for (int i = 0; i < 4; ++i)
#pragma unroll
            for (int j = 0; j < 2; ++j) { float v[4] = {acc[i][j][0], acc[i][j][1], acc[i][j][2], acc[i][j][3]}; e(bt, m0 + wm * 64 + i * 16 + fr, n0 + wn * 32 + j * 16 + 4 * fq, v); }
    }
    __syncthreads();
#endif
}
template <class E>
DEV void gemm_bf16(const Ctx& c, const bf16_t* A, int lda, const bf16_t* Wt, int M, int N, int K, const E& e) { EpiNoBatch<E> eb{e}; gemm_bf16_batched(c, A, lda, Wt, M, N, K, 1, 0, 0, eb); }

#ifndef EMU
namespace pg8 {
#define PG8_LAS __attribute__((address_space(3)))
typedef unsigned short bf16_t;
typedef short bf16x8 __attribute__((ext_vector_type(8)));
typedef float f32x4 __attribute__((ext_vector_type(4)));
typedef unsigned u32x4 __attribute__((ext_vector_type(4)));
constexpr int BM = 256, BK = 64, HALF = 128, HTB = HALF * BK * 2  , STAGE_BYTES = 8 * HTB, NXCD = 8, WGM = 8;

__host__ __device__ __forceinline__ int lds_byte(int r, int c) { const int st = (r >> 4) * 2 + (c >> 5), rr = r & 15, cc = c & 31, ob = rr * 64 + cc * 2; return st * 1024 + (ob ^ (((ob >> 9) & 1) << 5)); }
__host__ __device__ __forceinline__ void stage_rc(int b, int& R, int& C) { const int st = b / 1024, sb = b % 1024, swz = sb ^ (((sb >> 9) & 1) << 5); R = (st >> 1) * 16 + swz / 64; C = (st & 1) * 32 + (swz % 64) / 2; }
__host__ __device__ __forceinline__ int perm32(int rho) { const int n = rho >> 4, i = rho & 15; return 8 * (i >> 2) + 4 * n + (i & 3); }

struct Unit { int pm, pn, z; };
struct Gemm { const bf16_t* A; const bf16_t* Bt; int M, N, K, lda; size_t a_pn_off, a_z_off, b_z_off; };

struct StaticOrder {
    int nM, nN, nwg, G, c;
    __host__ __device__ void init(int M, int N, int G_, int c_) { nM = M / BM; nN = N / BM; nwg = nM * nN; G = G_; c = c_; }
    __host__ __device__ __forceinline__ bool next(int i, Unit& u) const {
        const long L = (long)i * G + c; if (L >= nwg) return false;
        int wgid = (int)L; { const int q = nwg / NXCD, r = nwg % NXCD, xcd = wgid % NXCD, off = wgid / NXCD; wgid = (xcd < r ? xcd * (q + 1) : r * (q + 1) + (xcd - r) * q) + off; }
        const int nig = WGM * nN, gid = wgid / nig, fm = gid * WGM, gsz = (nM - fm) < WGM ? (nM - fm) : WGM;
        u.pm = fm + ((wgid % nig) % gsz); u.pn = (wgid % nig) / gsz; u.z = 0; return true;
    }
    __device__ __forceinline__ void a_ready(const Unit&) const {}
    __device__ __forceinline__ void done(const Unit&) const {}
};


template <class F> struct EpiAdapt { static constexpr bool PERM = false, AFTER_DRAIN = false; F f;
    __device__ __forceinline__ void operator()(const f32x4 (&acc)[2][2][4][2], const Unit& u, int wr, int wc, int fr, int fq) const {
#pragma unroll
        for (int ai = 0; ai < 2; ++ai)
#pragma unroll
            for (int m = 0; m < 4; ++m) { const int row = u.pm * BM + ai * HALF + wr * 64 + m * 16 + fr;
#pragma unroll
                for (int bj = 0; bj < 2; ++bj)
#pragma unroll
                    for (int n = 0; n < 2; ++n) { const int col = u.pn * BM + bj * HALF + wc * 32 + n * 16 + 4 * fq; const f32x4 a = acc[ai][bj][m][n]; float v[4] = {a[0], a[1], a[2], a[3]}; f(row, col, v); } }
    }
};

template <int NZ> struct ZOrder { StaticOrder base;
    __host__ __device__ void init(int M, int N, int G_, int c_) { base.init(M, N, G_, c_); }
    __host__ __device__ __forceinline__ bool next(int i, Unit& u) const { if (!base.next(i / NZ, u)) return false; u.z = i % NZ; return true; }
    __device__ __forceinline__ void a_ready(const Unit&) const {}
    __device__ __forceinline__ void done(const Unit&) const {}
};
struct PlusOrder { StaticOrder base; int NX;
    __host__ __device__ void init(int M, int N, int G_, int c_, int nx) { base.init(M, N, G_, c_); NX = nx; }
    __host__ __device__ __forceinline__ bool next(int i, Unit& u) const { const long L = (long)i * base.G + base.c; if (L < base.nwg) return base.next(i, u); if (L >= base.nwg + NX) return false; u.pm = 0; u.pn = (int)(L - base.nwg); u.z = 1; return true; }
    __device__ __forceinline__ void a_ready(const Unit&) const {}
    __device__ __forceinline__ void done(const Unit&) const {}
};
template <class F> struct EpiAdapt8 { static constexpr bool PERM = true, AFTER_DRAIN = false; F f;
    __device__ __forceinline__ void operator()(const f32x4 (&acc)[2][2][4][2], const Unit& u, int wr, int wc, int fr, int fq) const {
#pragma unroll
        for (int ai = 0; ai < 2; ++ai)
#pragma unroll
            for (int m = 0; m < 4; ++m) { const int row = u.pm * BM + ai * HALF + wr * 64 + m * 16 + fr;
#pragma unroll
                for (int bj = 0; bj < 2; ++bj) { const int col = u.pn * BM + bj * HALF + wc * 32 + 8 * fq; const f32x4 a = acc[ai][bj][m][0], b = acc[ai][bj][m][1];
                    float v[8] = {a[0], a[1], a[2], a[3], b[0], b[1], b[2], b[3]}; f.op8(u.z, row, col, v); } }
    }
};
template <class Epi, class Sched, bool ALIGN_EPI = false, bool SP2 = false>
__device__ __forceinline__ void gemm_phase(PG8_LAS unsigned char* lds, const Gemm g, const Sched& S, const Epi& E, const int tid_in) {
    const int tid = tid_in;
    const int wid = __builtin_amdgcn_readfirstlane(tid >> 6), lane = tid & 63, wr = wid >> 2, wc = wid & 3, fr = lane & 15, fq = lane >> 4;
    const int K = g.K, nt = K / BK;
    unsigned voffA[2], voffB[2];
#pragma unroll
    for (int i = 0; i < 2; ++i) { int R, C; stage_rc(tid * 16 + i * 8192, R, C); const int Rb = Epi::PERM ? ((R & ~31) + perm32(R & 31)) : R;
        voffA[i] = (unsigned)(R * g.lda + C) * 2u; voffB[i] = (unsigned)(Rb * K + C) * 2u; }
    const size_t kstep = (size_t)(BK * 2);
    const size_t hstA = (size_t)HALF * g.lda * 2, hstB = (size_t)HALF * K * 2, tstA = 2 * hstA, tstB = 2 * hstB;
    const unsigned ldsw = (unsigned)wid * 1024u;
    const int aoff = lds_byte(wr * 64 + fr, fq * 8), boff = lds_byte(wc * 32 + fr, fq * 8);
#define PG8_SA(b, h) (((b) * 2 + (h)) * HTB)
#define PG8_SB(b, h) ((4 + (b) * 2 + (h)) * HTB)
#define PG8_STAGE(bufoff, gbase, voff) do { _Pragma("unroll") for (int _i = 0; _i < 2; ++_i) \
        __builtin_amdgcn_global_load_lds((const unsigned*)((const char*)(gbase) + (voff)[_i]), (PG8_LAS unsigned*)(lds + (bufoff) + ldsw + _i * 8192), 16, 0, 0); } while (0)
#define PG8_LDA(dst, b, h) do { _Pragma("unroll") for (int m = 0; m < 4; ++m) _Pragma("unroll") for (int k = 0; k < 2; ++k) dst[m][k] = *(const PG8_LAS bf16x8*)(lds + PG8_SA(b, h) + aoff + m * 2048 + k * 1024); } while (0)
#define PG8_LDB(dst, b, h) do { _Pragma("unroll") for (int n = 0; n < 2; ++n) _Pragma("unroll") for (int k = 0; k < 2; ++k) dst[n][k] = *(const PG8_LAS bf16x8*)(lds + PG8_SB(b, h) + boff + n * 2048 + k * 1024); } while (0)
#define PG8_MMA(ai, bj, At, Bt) do { __builtin_amdgcn_s_setprio(1); _Pragma("unroll") for (int m = 0; m < 4; ++m) _Pragma("unroll") for (int n = 0; n < 2; ++n) _Pragma("unroll") for (int k = 0; k < 2; ++k) \
        acc[ai][bj][m][n] = __builtin_amdgcn_mfma_f32_16x16x32_bf16(Bt[n][k], At[m][k], acc[ai][bj][m][n], 0, 0, 0); __builtin_amdgcn_s_setprio(0); } while (0)
#define PG8_WAIT_V(n) asm volatile("s_waitcnt vmcnt(" #n ")" ::: "memory")
#define PG8_WAIT_L(n) asm volatile("s_waitcnt lgkmcnt(" #n ")" ::: "memory")
#define PG8_BAR __builtin_amdgcn_s_barrier()
#define PG8_SCHED __builtin_amdgcn_sched_barrier(0)
    Unit cur, nxt; int ui = 0;
    if (!S.next(0, cur)) return;
    f32x4 acc[2][2][4][2];
#pragma unroll
    for (int a = 0; a < 2; ++a)
#pragma unroll
        for (int b = 0; b < 2; ++b)
#pragma unroll
            for (int m = 0; m < 4; ++m)
#pragma unroll
                for (int n = 0; n < 2; ++n) acc[a][b][m][n] = (f32x4){0.f, 0.f, 0.f, 0.f};
    bf16x8 At[4][2], B0[2][2], B1[2][2];
    const char* cA = (const char*)g.A + (size_t)cur.pm * tstA + (size_t)cur.pn * g.a_pn_off + (size_t)cur.z * g.a_z_off; const char* cB = (const char*)g.Bt + (size_t)cur.pn * tstB + (size_t)cur.z * g.b_z_off;
    S.a_ready(cur);
    if constexpr (SP2) {
        PG8_STAGE(PG8_SB(0, 0), cB, voffB); PG8_STAGE(PG8_SB(0, 1), cB + hstB, voffB); PG8_STAGE(PG8_SA(0, 0), cA, voffA); PG8_STAGE(PG8_SA(0, 1), cA + hstA, voffA);
        if (wr == 1) PG8_BAR;
        PG8_WAIT_V(2); PG8_BAR;
        PG8_STAGE(PG8_SB(1, 0), cB + kstep, voffB); PG8_STAGE(PG8_SA(1, 0), cA + kstep, voffA); PG8_STAGE(PG8_SB(1, 1), cB + hstB + kstep, voffB);
        PG8_WAIT_V(6); PG8_BAR;
    } else {
        PG8_STAGE(PG8_SB(0, 0), cB, voffB); PG8_STAGE(PG8_SA(0, 0), cA, voffA); PG8_STAGE(PG8_SB(0, 1), cB + hstB, voffB); PG8_STAGE(PG8_SA(0, 1), cA + hstA, voffA);
        if (wr == 1) PG8_BAR;
        PG8_WAIT_V(4); PG8_BAR;
        PG8_STAGE(PG8_SB(1, 0), cB + kstep, voffB); PG8_STAGE(PG8_SA(1, 0), cA + kstep, voffA); PG8_STAGE(PG8_SB(1, 1), cB + hstB + kstep, voffB);
        PG8_WAIT_V(6); PG8_BAR;
    }
    for (;;) {
        const bool has_next = S.next(ui + 1, nxt);
        const char* nA = has_next ? (const char*)g.A + (size_t)nxt.pm * tstA + (size_t)nxt.pn * g.a_pn_off + (size_t)nxt.z * g.a_z_off : cA; const char* nB = has_next ? (const char*)g.Bt + (size_t)nxt.pn * tstB + (size_t)nxt.z * g.b_z_off : cB;
        for (int t = 0; t < nt; t += 2) {
            const bool last = (t == nt - 2);
            const char* a1 = cA + (size_t)(t + 1) * kstep;
            const char* a2 = last ? nA : cA + (size_t)(t + 2) * kstep; const char* b2 = last ? nB : cB + (size_t)(t + 2) * kstep;
            const char* a3 = a2 + kstep; const char* b3 = b2 + kstep;
            if (last && has_next) S.a_ready(nxt);
            if constexpr (SP2) {
            PG8_LDB(B0, 0, 0); PG8_LDB(B1, 0, 1); PG8_SCHED; PG8_LDA(At, 0, 0); PG8_STAGE(PG8_SA(1, 1), a1 + hstA, voffA);
            PG8_WAIT_V(8); PG8_WAIT_L(0); PG8_BAR; PG8_MMA(0, 0, At, B0); PG8_MMA(0, 1, At, B1); PG8_BAR; PG8_SCHED;
            PG8_LDA(At, 0, 1); PG8_STAGE(PG8_SB(0, 0), b2, voffB); PG8_STAGE(PG8_SB(0, 1), b2 + hstB, voffB); PG8_STAGE(PG8_SA(0, 0), a2, voffA);
            PG8_WAIT_V(8); PG8_WAIT_L(0); PG8_BAR; PG8_MMA(1, 0, At, B0); PG8_MMA(1, 1, At, B1); PG8_BAR; PG8_SCHED;
            PG8_LDB(B0, 1, 0); PG8_LDB(B1, 1, 1); PG8_SCHED; PG8_LDA(At, 1, 0); PG8_STAGE(PG8_SA(0, 1), a2 + hstA, voffA);
            PG8_WAIT_V(8); PG8_WAIT_L(0); PG8_BAR; PG8_MMA(0, 0, At, B0); PG8_MMA(0, 1, At, B1); PG8_BAR; PG8_SCHED;
            PG8_LDA(At, 1, 1); PG8_STAGE(PG8_SB(1, 0), b3, voffB); PG8_STAGE(PG8_SB(1, 1), b3 + hstB, voffB); PG8_STAGE(PG8_SA(1, 0), a3, voffA);
            PG8_WAIT_V(8); PG8_WAIT_L(0); PG8_BAR; PG8_MMA(1, 0, At, B0); PG8_MMA(1, 1, At, B1); PG8_BAR; PG8_SCHED;
            } else {
            PG8_LDB(B0, 0, 0); PG8_SCHED; PG8_LDA(At, 0, 0); PG8_STAGE(PG8_SA(1, 1), a1 + hstA, voffA);
            PG8_WAIT_L(8); PG8_BAR; PG8_WAIT_L(0); PG8_MMA(0, 0, At, B0); PG8_BAR; PG8_SCHED;
            PG8_LDB(B1, 0, 1); PG8_STAGE(PG8_SB(0, 0), b2, voffB);
            PG8_BAR; PG8_WAIT_L(0); PG8_MMA(0, 1, At, B1); PG8_BAR;
            PG8_LDA(At, 0, 1); PG8_STAGE(PG8_SA(0, 0), a2, voffA);
            PG8_BAR; PG8_WAIT_L(0); PG8_MMA(1, 0, At, B0); PG8_BAR; PG8_SCHED;
            PG8_STAGE(PG8_SB(0, 1), b2 + hstB, voffB);
            PG8_WAIT_V(6); PG8_BAR; PG8_MMA(1, 1, At, B1); PG8_BAR;
            PG8_LDB(B0, 1, 0); PG8_SCHED; PG8_LDA(At, 1, 0); PG8_STAGE(PG8_SA(0, 1), a2 + hstA, voffA);
            PG8_WAIT_L(8); PG8_BAR; PG8_WAIT_L(0); PG8_MMA(0, 0, At, B0); PG8_BAR; PG8_SCHED;
            PG8_LDB(B1, 1, 1); PG8_STAGE(PG8_SB(1, 0), b3, voffB);
            PG8_BAR; PG8_WAIT_L(0); PG8_MMA(0, 1, At, B1); PG8_BAR;
            PG8_LDA(At, 1, 1); PG8_STAGE(PG8_SA(1, 0), a3, voffA);
            PG8_BAR; PG8_WAIT_L(0); PG8_MMA(1, 0, At, B0); PG8_BAR; PG8_SCHED;
            PG8_STAGE(PG8_SB(1, 1), b3 + hstB, voffB);
            PG8_WAIT_V(6); PG8_BAR; PG8_MMA(1, 1, At, B1); PG8_BAR;
            }
        }
        if constexpr (ALIGN_EPI) { if (wr == 0) PG8_BAR; }
        if constexpr (!Epi::AFTER_DRAIN) { const int lane_e = lane_id_fresh(); const int fr_e = lane_e & 15, fq_e = lane_e >> 4;
            E(acc, cur, wr, wc, fr_e, fq_e); S.done(cur); }
        if (!has_next) break;
#pragma unroll
        for (int a = 0; a < 2; ++a)
#pragma unroll
            for (int b = 0; b < 2; ++b)
#pragma unroll
                for (int m = 0; m < 4; ++m)
#pragma unroll
                    for (int n = 0; n < 2; ++n) acc[a][b][m][n] = (f32x4){0.f, 0.f, 0.f, 0.f};
        cur = nxt; cA = nA; cB = nB; ++ui;
        if constexpr (ALIGN_EPI) { if (wr == 1) PG8_BAR; }
    }
    PG8_WAIT_V(0);
    if constexpr (!ALIGN_EPI) { if (wr == 0) PG8_BAR; }
    PG8_BAR;
    if constexpr (Epi::AFTER_DRAIN) { E.fused(acc, cur, wr, wc, fr, fq, lds, wid, lane); S.done(cur); }
#undef PG8_SA
#undef PG8_SB
#undef PG8_STAGE
#undef PG8_LDA
#undef PG8_LDB
#undef PG8_MMA
#undef PG8_WAIT_V
#undef PG8_WAIT_L
#undef PG8_BAR
#undef PG8_SCHED
}
}

constexpr int PG8_LDS_BYTES = pg8::STAGE_BYTES;
#endif
template <class E>
DEV void gemm_big(const Ctx& c, const bf16_t* A, int lda, const bf16_t* Wt, int M, int N, int K, const E& e) {
#ifdef EMU
    gemm_bf16(c, A, lda, Wt, M, N, K, e);
#else
    pg8::Gemm g{A, Wt, M, N, K, lda, 0, 0, 0}; pg8::StaticOrder S; S.init(M, N, c.nb, c.bid);
    pg8::EpiAdapt8<E> ea{e};
    pg8::gemm_phase<pg8::EpiAdapt8<E>, pg8::StaticOrder, true, true>((PG8_LAS unsigned char*)g_lds, g, S, ea, c.tid);
    __syncthreads();
#endif
}

template <class E>
DEV void gemm_big_r(const Ctx& c, const bf16_t* A, int lda, const bf16_t* Wt, int M, int N, int K, const E& e);
template <class E> struct EpiColOff { const E& e; int off; DEV void operator()(int r, int c, const float* v) const { e(r, c + off, v); } };
template <class E>
DEV void gemm_blockdiag(const Ctx& c, const bf16_t* A, int lda, const bf16_t* Wt, int M, const E& e) {
#ifdef EMU
    for (int h = 0; h < 4; ++h) { EpiColOff<E> eo{e, h * 256}; gemm_bf16(c, A + h * 256, lda, Wt + (size_t)h * 65536, M, 256, 256, eo); }
#else
    pg8::Gemm g{A, Wt, M, 1024, 256, lda, 512, 0, 0}; pg8::StaticOrder S; S.init(M, 1024, c.nb, c.bid);
    pg8::EpiAdapt8<E> ea{e};
    pg8::gemm_phase<pg8::EpiAdapt8<E>, pg8::StaticOrder, true, true>((PG8_LAS unsigned char*)g_lds, g, S, ea, c.tid);
    __syncthreads();
#endif
}
#ifndef EMU
template <int K> DEV float shx(float v) { static_assert(K < 32, "shx: within 32-lane halves"); return __builtin_bit_cast(float, __builtin_amdgcn_ds_swizzle(__builtin_bit_cast(int, v), (K << 10) | 0x1f)); }
DEV float shx32(float v) { return __builtin_bit_cast(float, __builtin_amdgcn_ds_bpermute((lane_id_fresh() ^ 32) << 2, __builtin_bit_cast(int, v))); }
DEV float add32(float v) { return v + shx32(v); }
DEV float max32(float v) { return fmaxf(v, shx32(v)); }
DEV float wave_sum(float v) { v += shx<1>(v); v += shx<2>(v); v += shx<4>(v); v += shx<8>(v); v += shx<16>(v); return add32(v); }
DEV float wave_max(float v) { v = fmaxf(v, shx<1>(v)); v = fmaxf(v, shx<2>(v)); v = fmaxf(v, shx<4>(v)); v = fmaxf(v, shx<8>(v)); v = fmaxf(v, shx<16>(v)); return max32(v); }
DEV int bperm_i(int v, int src_lane) { return __builtin_amdgcn_ds_bpermute(src_lane << 2, v); }
DEV float bperm_f(float v, int src_lane) { return __builtin_bit_cast(float, __builtin_amdgcn_ds_bpermute(src_lane << 2, __builtin_bit_cast(int, v))); }
DEV unsigned pk2bf(float lo, float hi) { unsigned r; asm("v_cvt_pk_bf16_f32 %0, %1, %2" : "=v"(r) : "v"(lo), "v"(hi)); return r; }
typedef __bf16 bf16x2_t __attribute__((ext_vector_type(2)));
DEV float dot2bf(unsigned a, unsigned b, float acc) { return __builtin_amdgcn_fdot2_f32_bf16(__builtin_bit_cast(bf16x2_t, a), __builtin_bit_cast(bf16x2_t, b), acc, false); }
#endif

DEV void rmsnorm_rows_bf16(const Ctx& c, const float* x, const float* g, bf16_t* dst, int rows) {
#ifdef EMU
    for (int r = c.gtid; r < rows; r += c.gsize) {
        const float* xr = x + (size_t)r * D_; float ss = 0.f;
        for (int i = 0; i < D_; ++i) ss += xr[i] * xr[i];
        const float rs = 1.0f / sqrtf(ss * (1.0f / D_) + 1e-6f);
        for (int i = 0; i < D_; ++i) dst[(size_t)r * D_ + i] = f2bf(xr[i] * rs * g[i]);
    }
#else
    const int lane = c.tid & 63, gw = c.gtid >> 6, nw = c.gsize >> 6;
    for (int r = gw; r < rows; r += nw) { const f32x4* xr = (const f32x4*)(x + (size_t)r * D_) + lane; f32x4 v[4]; float ss = 0.f;
#pragma unroll
        for (int j = 0; j < 4; ++j) { v[j] = xr[64 * j]; ss += v[j][0] * v[j][0] + v[j][1] * v[j][1] + v[j][2] * v[j][2] + v[j][3] * v[j][3]; }
        const float rs = 1.0f / sqrtf(wave_sum(ss) * (1.0f / D_) + 1e-6f);
#pragma unroll
        for (int j = 0; j < 4; ++j) { const f32x4 gv = ((const f32x4*)g)[lane + 64 * j]; unsigned* o = (unsigned*)(dst + (size_t)r * D_ + 4 * lane + 256 * j);
            o[0] = pk2bf(v[j][0] * rs * gv[0], v[j][1] * rs * gv[1]); o[1] = pk2bf(v[j][2] * rs * gv[2], v[j][3] * rs * gv[3]); }
    }
#endif
}
DEV void atomic_add_f32(float* p, float v) {
#ifdef EMU
#pragma omp atomic
    *p += v;
#else
    atomicAdd(p, v);
#endif
}
DEV float rstd_from_ss(float ss) { return 1.0f / sqrtf(ss * (1.0f / D_) + 1e-6f); }
constexpr int SSW = 16;
DEV float row_rstd(const float* ssn, int row) {
#ifdef EMU
    return rstd_from_ss(ssn[(size_t)row * SSW]);
#else
    const f32x4* q = (const f32x4*)(ssn + (size_t)row * SSW); const f32x4 a = q[0], b = q[1], c2 = q[2], d = q[3];
    return rstd_from_ss((((a[0] + a[1]) + (a[2] + a[3])) + ((b[0] + b[1]) + (b[2] + b[3]))) + (((c2[0] + c2[1]) + (c2[2] + c2[3])) + ((d[0] + d[1]) + (d[2] + d[3]))));
#endif
}
struct EpiStoreBf16 { bf16_t* O; int ldo; float scale;
    DEV void operator()(int r, int c, const float* v) const { for (int j = 0; j < 4; ++j) O[(size_t)r * ldo + c + j] = f2bf(v[j] * scale); }
#ifndef EMU
    DEV void op8(int, int r, int c, const float* v) const { *(u32x4*)(O + (size_t)r * ldo + c) = (u32x4){pk2bf(v[0] * scale, v[1] * scale), pk2bf(v[2] * scale, v[3] * scale), pk2bf(v[4] * scale, v[5] * scale), pk2bf(v[6] * scale, v[7] * scale)}; }
#endif
};
struct EpiStoreF32 { float* O; int ldo;
    DEV void operator()(int r, int c, const float* v) const { for (int j = 0; j < 4; ++j) O[(size_t)r * ldo + c + j] = v[j]; }
#ifndef EMU
    DEV void op8(int, int r, int c, const float* v) const { f32x4* o = (f32x4*)(O + (size_t)r * ldo + c); o[0] = (f32x4){v[0], v[1], v[2], v[3]}; o[1] = (f32x4){v[4], v[5], v[6], v[7]}; }
#endif
};
struct EpiResidual { bf16_t* xb; float* ss;
    DEV void operator()(int r, int c, const float* v) const { float q = 0.f; for (int j = 0; j < 4; ++j) { const float x = bf2f(f2bf(bf2f(xb[(size_t)r * D_ + c + j]) + v[j])); xb[(size_t)r * D_ + c + j] = f2bf(x); q += x * x; }
        if (ss) atomic_add_f32(ss + (size_t)r * SSW, q); }
};
#ifndef EMU
struct EpiResidualPg8 { static constexpr bool PERM = true, AFTER_DRAIN = false; const bf16_t* src; bf16_t* xb; float* ss;
    __device__ __forceinline__ void operator()(const pg8::f32x4 (&acc)[2][2][4][2], const pg8::Unit& u, int wr, int wc, int fr, int fq) const {
#pragma unroll
        for (int ai = 0; ai < 2; ++ai)
#pragma unroll
            for (int m = 0; m < 4; ++m) { const int row = u.pm * 256 + ai * 128 + wr * 64 + m * 16 + fr; float q = 0.f;
#pragma unroll
                for (int bj = 0; bj < 2; ++bj) { const int col = u.pn * 256 + bj * 128 + wc * 32 + 8 * fq; const size_t o = (size_t)row * D_ + col;
                    const u32x4 xs = *(const u32x4*)(src + o); const f32x4 a0 = acc[ai][bj][m][0], a1 = acc[ai][bj][m][1]; u32x4 w;
                    w[0] = pk2bf(bf2f((bf16_t)(xs[0] & 0xffffu)) + a0[0], __uint_as_float(xs[0] & 0xffff0000u) + a0[1]); w[1] = pk2bf(bf2f((bf16_t)(xs[1] & 0xffffu)) + a0[2], __uint_as_float(xs[1] & 0xffff0000u) + a0[3]);
                    w[2] = pk2bf(bf2f((bf16_t)(xs[2] & 0xffffu)) + a1[0], __uint_as_float(xs[2] & 0xffff0000u) + a1[1]); w[3] = pk2bf(bf2f((bf16_t)(xs[3] & 0xffffu)) + a1[2], __uint_as_float(xs[3] & 0xffff0000u) + a1[3]);
                    *(u32x4*)(xb + o) = w;
#pragma unroll
                    for (int i = 0; i < 4; ++i) { const float lo = bf2f((bf16_t)(w[i] & 0xffffu)), hi = __uint_as_float(w[i] & 0xffff0000u); q += lo * lo + hi * hi; } }
                if (ss) { q += shx<16>(q); q = add32(q); if (fq == 0) ss[(size_t)row * SSW + u.pn * 4 + wc] = q; } }
    }
};
#endif

#ifndef EMU
template <class F> struct EpiAdapt8R { static constexpr bool PERM = true, AFTER_DRAIN = false; F f;
    __device__ __forceinline__ void operator()(const pg8::f32x4 (&acc)[2][2][4][2], const pg8::Unit& u, int wr, int wc, int fr, int fq) const {
        float rsv[2][4];
#pragma unroll
        for (int ai = 0; ai < 2; ++ai)
#pragma unroll
            for (int m = 0; m < 4; ++m) rsv[ai][m] = f.rs[u.pm * 256 + ai * 128 + wr * 64 + m * 16 + fr];
#pragma unroll
        for (int ai = 0; ai < 2; ++ai)
#pragma unroll
            for (int m = 0; m < 4; ++m) { const int row = u.pm * 256 + ai * 128 + wr * 64 + m * 16 + fr;
#pragma unroll
                for (int bj = 0; bj < 2; ++bj) { const int col = u.pn * 256 + bj * 128 + wc * 32 + 8 * fq; const pg8::f32x4 a = acc[ai][bj][m][0], b = acc[ai][bj][m][1];
                    float v[8] = {a[0], a[1], a[2], a[3], b[0], b[1], b[2], b[3]}; f.op8r(row, col, v, rsv[ai][m]); } }
    }
};
#endif
struct EpiRowScaleBf16 { bf16_t* O; int ldo; float scale; const float* ss; const float* rs;
    DEV void operator()(int r, int c, const float* v) const { const float rs = scale * row_rstd(ss, r); for (int j = 0; j < 4; ++j) O[(size_t)r * ldo + c + j] = f2bf(v[j] * rs); }
#ifndef EMU
    DEV void op8r(int r, int c, const float* v, float rs0) const { const float rs = scale * rs0; *(u32x4*)(O + (size_t)r * ldo + c) = (u32x4){pk2bf(v[0] * rs, v[1] * rs), pk2bf(v[2] * rs, v[3] * rs), pk2bf(v[4] * rs, v[5] * rs), pk2bf(v[6] * rs, v[7] * rs)}; }
#endif
};
struct EpiRowScaleF32 { float* O; int ldo; const float* ss; const float* rs;
    DEV void operator()(int r, int c, const float* v) const { const float rs = row_rstd(ss, r); for (int j = 0; j < 4; ++j) O[(size_t)r * ldo + c + j] = v[j] * rs; }
#ifndef EMU
    DEV void op8r(int r, int c, const float* v, float rs) const { bf16_t* o = (bf16_t*)O + ((size_t)((r >> 8) * (ldo >> 8) + (c >> 8)) << 16) + ((size_t)(c & 255) << 8) + (r & 255);
#pragma unroll
        for (int j = 0; j < 8; ++j) o[j * 256] = f2bf(v[j] * rs); }
#endif
};
#ifndef EMU
template <class Sched> DEV void prep_rstd(const Ctx& c, const float* ssn, float* rs, const Sched& S) {
    pg8::Unit u; int last = -1;
    for (int i = 0; S.next(i, u); ++i) { if (u.pm != last && c.tid < 256) rs[u.pm * 256 + c.tid] = row_rstd(ssn, u.pm * 256 + c.tid); last = u.pm; }
    asm volatile("s_waitcnt vmcnt(0)" ::: "memory"); __syncthreads();
}
#endif
template <class E>
DEV void gemm_big_r(const Ctx& c, const bf16_t* A, int lda, const bf16_t* Wt, int M, int N, int K, const E& e) {
#ifdef EMU
    gemm_bf16(c, A, lda, Wt, M, N, K, e);
#else
    pg8::Gemm g{A, Wt, M, N, K, lda, 0, 0, 0}; pg8::StaticOrder S; S.init(M, N, c.nb, c.bid);
    prep_rstd(c, e.ss, const_cast<float*>(e.rs), S);
    EpiAdapt8R<E> ea{e};
    pg8::gemm_phase<EpiAdapt8R<E>, pg8::StaticOrder, true, true>((PG8_LAS unsigned char*)g_lds, g, S, ea, c.tid);
    __syncthreads();
#endif
}

struct EpiBranch { int b; const bf16_t* P; float* tmp; bf16_t* mixb;
    DEV void operator()(int r, int c, const float* v) const {
        for (int j = 0; j < 4; ++j) { const float g = bf2f(P[PI(r, C_GT + b * D_ + c + j)]); const size_t o = (size_t)r * D_ + c + j;
            float t = g * v[j]; if (b > 0) t += tmp[o]; if (b < 2) tmp[o] = t; else mixb[o] = f2bf(t); } } };
#ifndef EMU
struct EpiBranch8 { const bf16_t* P; bf16_t* tmp; bf16_t* mixb;
    DEV void op8(int z, int r, int c, const float* v) const {
        const u32x4 g = *(const u32x4*)(P + PI(r, C_GT + z * D_ + c)); float t[8];
#pragma unroll
        for (int i = 0; i < 4; ++i) { t[2 * i] = bf2f((bf16_t)(g[i] & 0xffffu)) * v[2 * i]; t[2 * i + 1] = __uint_as_float(g[i] & 0xffff0000u) * v[2 * i + 1]; }
        if (z > 0) { const u32x4 o = *(const u32x4*)(tmp + (size_t)r * D_ + c);
#pragma unroll
            for (int i = 0; i < 4; ++i) { t[2 * i] += bf2f((bf16_t)(o[i] & 0xffffu)); t[2 * i + 1] += __uint_as_float(o[i] & 0xffff0000u); } }
        *(u32x4*)((z < 2 ? tmp : mixb) + (size_t)r * D_ + c) = (u32x4){pk2bf(t[0], t[1]), pk2bf(t[2], t[3]), pk2bf(t[4], t[5]), pk2bf(t[6], t[7])};
    } };
#endif
struct EpiInProj { bf16_t* P; float* lgf; const float* lb; const int* pos; const float* ss;
    DEV void operator()(int r, int c, const float* vin) const {
        float o[4], v[4]; { const float rs = row_rstd(ss, r); for (int j = 0; j < 4; ++j) v[j] = vin[j] * rs; }
        if (c < C_HF) { for (int j = 0; j < 4; ++j) o[j] = siluf_(v[j]) * 0.08838834764831845f; }
        else if (c < C_HI) { for (int j = 0; j < 4; ++j) { const float l = lb[c - C_HF + j], z = v[j]; const float f = l + (1.0f - l) * sigmoidf_(z);
                lgf[(size_t)r * 512 + (c - C_HF) + j] = logf_safe(f); o[j] = (1.0f - l) * sigmoidf_(-z); } }
        else if (c < C_HG) { for (int j = 0; j < 4; ++j) o[j] = v[j]; }
        else if (c < C_RQ) { for (int j = 0; j < 4; ++j) o[j] = siluf_(v[j]); }
        else if (c < C_RV) { const float sc = (c >= C_RK) ? 0.08838834764831845f : 1.0f; const float p = (float)pos[r];
            for (int q = 0; q < 2; ++q) { const int i = ((c & 127) >> 1) + q; const float invf = exp2f(-(float)i * (13.287712379549449f / 63.0f)); const float ang = p * invf;
                const float cs = cosf(ang), sn = sinf(ang), a1 = v[2 * q], a2 = v[2 * q + 1]; o[2 * q] = (a1 * cs - a2 * sn) * sc; o[2 * q + 1] = (a2 * cs + a1 * sn) * sc; } }
        else if (c < C_RG) { for (int j = 0; j < 4; ++j) o[j] = v[j]; }
        else if (c < C_SQ) { for (int j = 0; j < 4; ++j) o[j] = siluf_(v[j]); }
        else if (c < C_SV) { const float sc = (c < C_SK) ? 0.125f : 1.0f; const float p = (float)pos[r]; const int cc = (c < C_SK) ? (c - C_SQ) : (c - C_SK);
            for (int q = 0; q < 2; ++q) { const int i = ((cc & 63) >> 1) + q; const float invf = exp2f(-(float)i * (13.287712379549449f / 32.0f)); const float ang = p * invf;
                const float cs = cosf(ang), sn = sinf(ang), a1 = v[2 * q], a2 = v[2 * q + 1]; o[2 * q] = (a1 * cs - a2 * sn) * sc; o[2 * q + 1] = (a2 * cs + a1 * sn) * sc; } }
        else if (c < C_GT) { for (int j = 0; j < 4; ++j) o[j] = v[j]; }
        else { for (int j = 0; j < 4; ++j) o[j] = sigmoidf_(v[j]); }
        for (int j = 0; j < 4; ++j) P[PI(r, c + j)] = f2bf(o[j]);
    }
    static DEV float logf_safe(float f) { return logf(fmaxf(f, 1e-30f)); }
};


#ifndef EMU
struct EpiInProjPg8 { static constexpr bool PERM = true, AFTER_DRAIN = false; bf16_t* P; float* lgf; const float* lb; const int* pos; const float* rs; bf16_t* kxh; bf16_t* vxt;
    __device__ __forceinline__ void operator()(const pg8::f32x4 (&acc)[2][2][4][2], const pg8::Unit& u, int wr, int wc, int fr, int fq) const {
        if (u.z == 1) {
#pragma unroll
            for (int ai = 0; ai < 2; ++ai)
#pragma unroll
                for (int m = 0; m < 4; ++m) { const int row = ai * 128 + wr * 64 + m * 16 + fr;
#pragma unroll
                    for (int bj = 0; bj < 2; ++bj) { const int col = u.pn * 256 + bj * 128 + wc * 32 + 8 * fq; const pg8::f32x4 a = acc[ai][bj][m][0], b = acc[ai][bj][m][1];
                        if (col < 1024) { const int h = col >> 8, d = col & 255; *(u32x4*)(kxh + ((size_t)h * 256 + row) * 256 + d) = (u32x4){pk2bf(a[0], a[1]), pk2bf(a[2], a[3]), pk2bf(b[0], b[1]), pk2bf(b[2], b[3])}; }
                        else { const int cc = col - 1024, h = cc >> 8, d = cc & 255; const float v8[8] = {a[0], a[1], a[2], a[3], b[0], b[1], b[2], b[3]};
#pragma unroll
                            for (int j = 0; j < 8; ++j) vxt[((size_t)h * 256 + d + j) * 256 + row] = f2bf(v8[j]); } } }
            return; }
        int cl = wc * 32 + 8 * fq;
        asm volatile("" : "+v"(cl));
        float invr[4], invs[4], rsv[2][4];
#pragma unroll
        for (int ai = 0; ai < 2; ++ai)
#pragma unroll
            for (int m = 0; m < 4; ++m) rsv[ai][m] = rs[u.pm * 256 + ai * 128 + wr * 64 + m * 16 + fr];
#pragma unroll
        for (int q = 0; q < 4; ++q) { invr[q] = exp2f(-(float)((cl >> 1) + q) * (13.287712379549449f / 63.0f)); invs[q] = exp2f(-(float)(((cl & 63) >> 1) + q) * (13.287712379549449f / 32.0f)); }
#pragma unroll
        for (int bj = 0; bj < 2; ++bj) {
            const int cb = u.pn * 256 + bj * 128, c0 = cb + cl;
            int ty; float sc = 1.0f;
            if (cb < C_HF) { ty = 0; sc = 0.08838834764831845f; } else if (cb < C_HI) ty = 1; else if (cb < C_HG) ty = 2; else if (cb < C_RQ) ty = 0;
            else if (cb < C_RV) { ty = 3; sc = (cb >= C_RK) ? 0.08838834764831845f : 1.0f; } else if (cb < C_RG) ty = 2; else if (cb < C_SQ) ty = 0;
            else if (cb < C_SV) { ty = 4; sc = (cb < C_SK) ? 0.125f : 1.0f; } else if (cb < C_GT) ty = 2; else ty = 5;
            float lbv[8];
            if (ty == 1) {
#pragma unroll
                for (int j = 0; j < 8; ++j) lbv[j] = lb[c0 - C_HF + j]; }
#pragma unroll
            for (int ai = 0; ai < 2; ++ai)
#pragma unroll
                for (int m = 0; m < 4; ++m) {
                    const int row = u.pm * 256 + ai * 128 + wr * 64 + m * 16 + fr;
                    float v[8], o[8]; const float rs = rsv[ai][m];
#pragma unroll
                    for (int j = 0; j < 8; ++j) v[j] = acc[ai][bj][m][j >> 2][j & 3] * rs;
                    if (ty == 0) {
#pragma unroll
                        for (int j = 0; j < 8; ++j) o[j] = v[j] * sc * __builtin_amdgcn_rcpf(1.0f + __expf(-v[j])); }
                    else if (ty == 1) { float lf[8];
#pragma unroll
                        for (int j = 0; j < 8; ++j) { const float sg = __builtin_amdgcn_rcpf(1.0f + __expf(-v[j])); const float f = lbv[j] + (1.0f - lbv[j]) * sg; lf[j] = __logf(fmaxf(f, 1e-30f)); o[j] = (1.0f - lbv[j]) * (1.0f - sg); }
                        float* lp = lgf + (size_t)row * 512 + (c0 - C_HF); *(pg8::f32x4*)lp = (pg8::f32x4){lf[0], lf[1], lf[2], lf[3]}; *(pg8::f32x4*)(lp + 4) = (pg8::f32x4){lf[4], lf[5], lf[6], lf[7]}; }
                    else if (ty == 2) {
#pragma unroll
                        for (int j = 0; j < 8; ++j) o[j] = v[j]; }
                    else if (ty == 3 || ty == 4) { const float pf = (float)pos[row];
#pragma unroll
                        for (int q = 0; q < 4; ++q) { const float ang = pf * (ty == 3 ? invr[q] : invs[q]); float rev = ang * 0.15915494309189535f; rev = rev - floorf(rev);
                            const float sn = __builtin_amdgcn_sinf(rev), cs = __builtin_amdgcn_cosf(rev), a1 = v[2 * q], a2 = v[2 * q + 1]; o[2 * q] = (a1 * cs - a2 * sn) * sc; o[2 * q + 1] = (a2 * cs + a1 * sn) * sc; } }
                    else {
#pragma unroll
                        for (int j = 0; j < 8; ++j) o[j] = __builtin_amdgcn_rcpf(1.0f + __expf(-v[j])); }
                    pg8::u32x4 w; w.x = pk2bf(o[0], o[1]); w.y = pk2bf(o[2], o[3]);
                    w.z = pk2bf(o[4], o[5]); w.w = pk2bf(o[6], o[7]);
                    *(pg8::u32x4*)(P + PI(row, c0)) = w;
                }
        }
    }
};
#endif
#ifndef EMU
struct EpiSoftmaxPg8 { static constexpr bool PERM = true, AFTER_DRAIN = true; bf16_t* PX;
    __device__ __forceinline__ void fused(pg8::f32x4 (&acc)[2][2][4][2], const pg8::Unit& u, int wr, int wc, int fr, int fq, PG8_LAS unsigned char* lds, int wid, int lane) const {
        PG8_LAS float* pm = (PG8_LAS float*)lds;
        PG8_LAS float* ps = (PG8_LAS float*)(lds + 4096);
        float mx[2][4];
#pragma unroll
        for (int ai = 0; ai < 2; ++ai)
#pragma unroll
            for (int m = 0; m < 4; ++m) { float v = -3.0e38f;
#pragma unroll
                for (int bj = 0; bj < 2; ++bj)
#pragma unroll
                    for (int n = 0; n < 2; ++n) { const pg8::f32x4 a = acc[ai][bj][m][n]; v = fmaxf(v, fmaxf(fmaxf(a[0], a[1]), fmaxf(a[2], a[3]))); }
                v = fmaxf(v, shx<16>(v)); v = max32(v); mx[ai][m] = v;
                if (fq == 0) pm[(ai * 128 + wr * 64 + m * 16 + fr) * 4 + wc] = v; }
        __syncthreads();
        float sm[2][4];
#pragma unroll
        for (int ai = 0; ai < 2; ++ai)
#pragma unroll
            for (int m = 0; m < 4; ++m) { const int r = ai * 128 + wr * 64 + m * 16 + fr; const float gm = fmaxf(fmaxf(pm[r * 4 + 0], pm[r * 4 + 1]), fmaxf(pm[r * 4 + 2], pm[r * 4 + 3])); float sacc = 0.f;
#pragma unroll
                for (int bj = 0; bj < 2; ++bj)
#pragma unroll
                    for (int n = 0; n < 2; ++n) { pg8::f32x4 a = acc[ai][bj][m][n]; a[0] = __expf(a[0] - gm); a[1] = __expf(a[1] - gm); a[2] = __expf(a[2] - gm); a[3] = __expf(a[3] - gm); acc[ai][bj][m][n] = a; sacc += (a[0] + a[1]) + (a[2] + a[3]); }
                sacc += shx<16>(sacc); sacc = add32(sacc); sm[ai][m] = sacc;
                if (fq == 0) ps[r * 4 + wc] = sacc; }
        __syncthreads();
#pragma unroll
        for (int ai = 0; ai < 2; ++ai)
#pragma unroll
            for (int m = 0; m < 4; ++m) { const int r = ai * 128 + wr * 64 + m * 16 + fr; const float inv = __builtin_amdgcn_rcpf((ps[r * 4 + 0] + ps[r * 4 + 1]) + (ps[r * 4 + 2] + ps[r * 4 + 3]));
#pragma unroll
                for (int bj = 0; bj < 2; ++bj) { const pg8::f32x4 a = acc[ai][bj][m][0] * inv, b = acc[ai][bj][m][1] * inv;
                    *(u32x4*)(PX + (size_t)(u.pm * 256 + r) * D_ + u.pn * 256 + bj * 128 + wc * 32 + 8 * fq) = (u32x4){pk2bf(a[0], a[1]), pk2bf(a[2], a[3]), pk2bf(b[0], b[1]), pk2bf(b[2], b[3])}; } }
        (void)mx; (void)sm; (void)wid; (void)lane;
    }
};
#endif
struct EpiKXh { bf16_t* O;
    DEV void operator()(int r, int c, const float* v) const { const int h = c >> 8, d = c & 255; for (int j = 0; j < 4; ++j) O[((size_t)h * 256 + r) * 256 + d + j] = f2bf(v[j]); } };
struct EpiVXT { bf16_t* O;
    DEV void operator()(int r, int c, const float* v) const { const int h = c >> 8, d = c & 255; for (int j = 0; j < 4; ++j) O[((size_t)h * 256 + d + j) * 256 + r] = f2bf(v[j]); } };
struct EpiLS { bf16_t* LS; const float* VEC;
    DEV void operator()(int bt, int r, int cc, const float* v) const { for (int j = 0; j < 4; ++j) LS[((size_t)bt * 128 + r) * 128 + cc + j] = f2bf(v[j] * VEC[(size_t)bt * 384 + 256 + cc + j]); } };

DEV unsigned fkey(float x) { unsigned u = __float_as_uint(x); return (u & 0x80000000u) ? ~u : (u | 0x80000000u); }
DEV float fkey_inv(unsigned k) { return __uint_as_float((k & 0x80000000u) ? (k & 0x7fffffffu) : ~k); }
DEV void ce_desc(unsigned& a, unsigned& b) { const unsigned hi = a > b ? a : b, lo = a > b ? b : a; a = hi; b = lo; }
DEV void bitonic_sort16_desc(unsigned (&a)[16]) {
#pragma unroll
    for (int k = 2; k <= 16; k <<= 1)
#pragma unroll
        for (int j = k >> 1; j > 0; j >>= 1)
#pragma unroll
            for (int i = 0; i < 16; ++i) { const int l = i ^ j; if (l > i) { if ((i & k) == 0) ce_desc(a[i], a[l]); else ce_desc(a[l], a[i]); } }
}
DEV void merge_top16(unsigned (&t)[16], const unsigned (&g)[16]) {
#pragma unroll
    for (int i = 0; i < 16; ++i) t[i] = t[i] > g[15 - i] ? t[i] : g[15 - i];
#pragma unroll
    for (int j = 8; j > 0; j >>= 1)
#pragma unroll
        for (int i = 0; i < 16; ++i) { const int l = i ^ j; if (l > i) ce_desc(t[i], t[l]); }
}
constexpr int cand_pos(int a, int b) { int n = 0; for (int x = 0; x < 16; ++x) for (int y = 0; y < 16; ++y) { if (x == a && y == b) return n; if ((x + 1) * (y + 1) <= 16) ++n; } return n; }
static_assert(cand_pos(15, 0) == 49, "50 candidate pairs");
template <int A, int B> struct CandPos { static constexpr int v = cand_pos(A, B); };
template <int A, int B> DEV void cand_fill_b(unsigned (&ck)[64], const float (&v0)[16], const float (&v1)[16]) {
    if constexpr ((A + 1) * (B + 1) <= 16) { ck[CandPos<A, B>::v] = (fkey(v0[A] + v1[B]) & ~255u) | (unsigned)(A * 16 + B); }
    if constexpr (B + 1 < 16) cand_fill_b<A, B + 1>(ck, v0, v1);
}
template <int A> DEV void cand_fill_a(unsigned (&ck)[64], const float (&v0)[16], const float (&v1)[16]) { cand_fill_b<A, 0>(ck, v0, v1); if constexpr (A + 1 < 16) cand_fill_a<A + 1>(ck, v0, v1); }
struct Lay {
    const float *ln_mix, *w_in, *lb_param, *hgrn_norm, *sinks, *w_br[3], *w_out, *ln_xq, *ln_xkv, *w_xq, *w_xk, *w_xv, *w_xo, *ln_ffn, *peer_wq, *peer_keys, *peer_u, *peer_v;
};
DEV Lay make_lay(const Params& p, int l) {
    Lay L; L.ln_mix = p.in[3] + (size_t)l * D_; L.w_in = p.in[4] + (size_t)l * D_ * NIN; L.lb_param = p.in[5]; L.hgrn_norm = p.in[6] + (size_t)l * 512; L.sinks = p.in[7] + l * 8;
    L.w_br[0] = p.in[8] + (size_t)l * 512 * D_; L.w_br[1] = p.in[9] + (size_t)l * 512 * D_; L.w_br[2] = p.in[10] + (size_t)l * 512 * D_;
    L.w_out = p.in[11] + (size_t)l * D_ * D_; L.ln_xq = p.in[12] + (size_t)l * D_; L.ln_xkv = p.in[13] + (size_t)l * D_;
    L.w_xq = p.in[14] + (size_t)l * D_ * D_; L.w_xk = p.in[15] + (size_t)l * D_ * D_; L.w_xv = p.in[16] + (size_t)l * D_ * D_; L.w_xo = p.in[17] + (size_t)l * D_ * D_;
    L.ln_ffn = p.in[18] + (size_t)l * D_; L.peer_wq = p.in[19] + (size_t)l * D_ * 2048; L.peer_keys = p.in[20] + (size_t)l * 2 * 8 * 128 * 128;
    L.peer_u = p.in[21] + (size_t)l * 16384 * D_; L.peer_v = p.in[22] + (size_t)l * 16384 * D_; return L;
}
#define WSP(type, off) ((type*)(p.ws + (off)))

constexpr int N_STAGES_PER_LAYER = 20;
constexpr int N_STAGES = DEPTH * N_STAGES_PER_LAYER + 1;

DEV void run_final(const Params& p) {
    const Ctx c = make_ctx(); const int T = p.T;
    const float* g = p.in[23];
#ifdef EMU
    for (int r = c.gtid; r < T; r += c.gsize) { float* xr = p.out + (size_t)r * D_; float ss = 0.f; for (int i = 0; i < D_; ++i) ss += xr[i] * xr[i];
        const float rs = 1.0f / sqrtf(ss * (1.0f / D_) + 1e-6f); for (int i = 0; i < D_; ++i) xr[i] = xr[i] * rs * g[i]; }
#else
    const int lane = c.tid & 63, gw = c.gtid >> 6, nw = c.gsize >> 6;
    for (int r = gw; r < T; r += nw) { f32x4* xr = (f32x4*)(p.out + (size_t)r * D_) + lane; f32x4 v[4]; float ss = 0.f;
#pragma unroll
        for (int j = 0; j < 4; ++j) { v[j] = xr[64 * j]; ss += v[j][0] * v[j][0] + v[j][1] * v[j][1] + v[j][2] * v[j][2] + v[j][3] * v[j][3]; }
        const float rs = 1.0f / sqrtf(wave_sum(ss) * (1.0f / D_) + 1e-6f);
#pragma unroll
        for (int j = 0; j < 4; ++j) { const f32x4 gv = ((const f32x4*)g)[lane + 64 * j]; xr[64 * j] = (f32x4){v[j][0] * rs * gv[0], v[j][1] * rs * gv[1], v[j][2] * rs * gv[2], v[j][3] * rs * gv[3]}; }
    }
#endif
}
DEV void run_stage_ls(const Params& p, const int l_in, const int s, const bool dry = false, const int wave_u = -1) {
    int l = l_in;
#ifndef EMU
    asm volatile("" : "+s"(l));
#endif
    const Ctx c = make_ctx(wave_u);
    const int T = p.T;
#ifdef ONLY_STAGE
    if (s != ONLY_STAGE) return;
#endif
    const Lay L = make_lay(p, l);
    const float* xsrc = (l == 0) ? p.in[0] : p.out;
    const int* pos = (const int*)p.in[2];
    bf16_t* P = WSP(bf16_t, WS_P); bf16_t* HB = WSP(bf16_t, WS_HB); bf16_t* OBUF = WSP(bf16_t, WS_OBUF);
    float* SS = WSP(float, WS_SS);
    switch (s) {
    case 0: {
        bf16_t* wt = WSP(bf16_t, WS_WT_IN);
#ifdef EMU
        cvt_transpose<0>(c, L.w_in, NIN, 0, D_, 2048, wt, L.ln_mix);
        cvt_transpose<1>(c, L.w_in, NIN, C_RQ, D_, 1024, wt + (size_t)C_RQ * D_, L.ln_mix);
        cvt_transpose<0>(c, L.w_in, NIN, C_RV, D_, 1024, wt + (size_t)C_RV * D_, L.ln_mix);
        cvt_transpose<2>(c, L.w_in, NIN, C_SQ, D_, 640, wt + (size_t)C_SQ * D_, L.ln_mix);
        cvt_transpose<0>(c, L.w_in, NIN, C_SV, D_, NIN - C_SV, wt + (size_t)C_SV * D_, L.ln_mix);
        for (int b = 0; b < 3; ++b) cvt_transpose<0>(c, L.w_br[b], D_, 0, 512, D_, WSP(bf16_t, WS_WT_BR) + (size_t)b * D_ * 512);
        cvt_transpose<0>(c, L.w_out, D_, 0, D_, D_, WSP(bf16_t, WS_WT_OUT));
        cvt_transpose<0>(c, L.w_xq, D_, 0, D_, D_, WSP(bf16_t, WS_WT_XQ), L.ln_xq);
        cvt_transpose<0>(c, L.w_xk, D_, 0, D_, D_, WSP(bf16_t, WS_WT_XK));
        cvt_transpose<0>(c, L.w_xv, D_, 0, D_, D_, WSP(bf16_t, WS_WT_XV));
        cvt_transpose<0>(c, L.w_xo, D_, 0, D_, D_, WSP(bf16_t, WS_WT_XO));
#else
        {
            float* Ls = (float*)g_lds; const int tid = c.tid;
            constexpr int NT_IN = 16 * 62, NT_BR = 8 * 8, NT_SQ = 16 * 8, NT_ALL = NT_IN + 3 * NT_BR + 5 * NT_SQ;
            for (int tile = c.bid; tile < NT_ALL; tile += c.nb) {
                const float* src; bf16_t* dst; const float* gain = nullptr; int K, N, tl = tile, mode = 0;
                if (tl < NT_IN) { src = L.w_in; dst = wt; K = D_; N = NIN; gain = L.ln_mix; }
                else if ((tl -= NT_IN) < 3 * NT_BR) { const int bb = tl / NT_BR; tl -= bb * NT_BR; src = L.w_br[0]; if (bb == 1) src = L.w_br[1]; if (bb == 2) src = L.w_br[2]; dst = WSP(bf16_t, WS_WT_BR) + (size_t)bb * D_ * 512; K = 512; N = D_; }
                else { tl -= 3 * NT_BR; const int mm = tl / NT_SQ; tl -= mm * NT_SQ; K = D_; N = D_;
                    src = L.w_out; dst = WSP(bf16_t, WS_WT_OUT);
                    if (mm == 1) { src = L.w_xq; dst = WSP(bf16_t, WS_WT_XQ); gain = L.ln_xq; } if (mm == 2) { src = L.w_xk; dst = WSP(bf16_t, WS_WT_XK); }
                    if (mm == 3) { src = L.w_xv; dst = WSP(bf16_t, WS_WT_XV); } if (mm == 4) { src = L.w_xo; dst = WSP(bf16_t, WS_WT_XO); } }
                const int nkt = K / 64, kt = tl % nkt, nb = tl / nkt, k0 = kt * 64, n0 = nb * 128;
                if (tile < NT_IN) { if (nb >= 16 && nb < 24) mode = 1; else if (nb >= 32 && nb < 37) mode = 2; }
                __syncthreads();
#pragma unroll
                for (int i = 0; i < 4; ++i) { const int kr = (tid >> 5) + 16 * i, nc = 4 * (tid & 31); const f32x4 v = *(const f32x4*)(src + (size_t)(k0 + kr) * N + n0 + nc) * (gain ? gain[k0 + kr] : 1.0f);
                    Ls[kr * 129 + nc] = v[0]; Ls[kr * 129 + nc + 1] = v[1]; Ls[kr * 129 + nc + 2] = v[2]; Ls[kr * 129 + nc + 3] = v[3]; }
                __syncthreads();
                const int j = tid >> 2, kq = tid & 3; int sj = j;
                if (mode == 1) sj = (j & 1) ? 64 + (j >> 1) : (j >> 1);
                if (mode == 2) { const int jj = j & 63; sj = (j & 64) + ((jj & 1) ? 32 + (jj >> 1) : (jj >> 1)); }
                u32x4 o0, o1;
#pragma unroll
                for (int i = 0; i < 4; ++i) { o0[i] = pk2bf(Ls[(16 * kq + 2 * i) * 129 + sj], Ls[(16 * kq + 2 * i + 1) * 129 + sj]); o1[i] = pk2bf(Ls[(16 * kq + 8 + 2 * i) * 129 + sj], Ls[(16 * kq + 9 + 2 * i) * 129 + sj]); }
                bf16_t* dp = dst + (size_t)(n0 + j) * K + k0 + 16 * kq; *(u32x4*)dp = o0; *(u32x4*)(dp + 8) = o1;
            }
            __syncthreads();
        }
#endif
        float* lb = WSP(float, WS_LB);
        for (int i = c.gtid; i < 512; i += c.gsize) { float mx = -1e30f; for (int d = 0; d < DEPTH; ++d) mx = fmaxf(mx, L.lb_param[d * 512 + i]);
            float den = 0.f, num = 0.f; for (int d = 0; d < DEPTH; ++d) { const float ev = expf(L.lb_param[d * 512 + i] - mx); den += ev; if (d >= 1 && d <= l) num += ev; } lb[l * 512 + i] = num / den; }
        rmsnorm_rows_bf16(c, p.in[1], L.ln_xkv, WSP(bf16_t, WS_HM), NMEM);
        if (l == 0) {
#ifdef EMU
            for (int r = c.gtid; r < T; r += c.gsize) { float q = 0.f; for (int i = 0; i < D_; ++i) { const float x = xsrc[(size_t)r * D_ + i]; q += x * x; HB[(size_t)r * D_ + i] = f2bf(x); } SS[(size_t)r * SSW] = q; }
#else
            { const int lane = c.tid & 63, gw = c.gtid >> 6, nw = c.gsize >> 6;
              for (int r = gw; r < T; r += nw) { const f32x4* xr = (const f32x4*)(xsrc + (size_t)r * D_) + lane; float q = 0.f;
#pragma unroll
                  for (int j = 0; j < 4; ++j) { const f32x4 v = xr[64 * j]; q += (v[0] * v[0] + v[1] * v[1]) + (v[2] * v[2] + v[3] * v[3]); unsigned* o = (unsigned*)(HB + (size_t)r * D_ + 4 * lane + 256 * j); o[0] = pk2bf(v[0], v[1]); o[1] = pk2bf(v[2], v[3]); }
                  q = wave_sum(q); if (lane < 4) ((f32x4*)(SS + (size_t)r * SSW))[lane] = (f32x4){lane == 0 ? q : 0.f, 0.f, 0.f, 0.f}; } }
#endif
        }
    } break;
    case 1: {
        bf16_t* we = WSP(bf16_t, WS_WT_EFF);
#ifdef EMU
        for (long i = c.gtid; i < 2048L * D_; i += c.gsize) { const int n = (int)(i / D_), k = (int)(i % D_); const int h = n >> 8, pp = (n >> 7) & 1, key = n & 127;
            const float* wq = L.peer_wq + (size_t)k * 2048 + h * 256 + pp * 128; const float* kk = L.peer_keys + ((size_t)(pp * 8 + h) * 128 + key) * 128;
            float sacc = 0.f; for (int d = 0; d < 128; ++d) sacc += wq[d] * kk[d]; we[i] = f2bf(sacc * L.ln_ffn[k]); }
#else
        {
            float* Ks = (float*)g_lds; float* Ws = Ks + 128 * 128; const int tid = c.tid, tx = tid & 31, ty = tid >> 5;
            for (int task = c.bid; task < 256; task += c.nb) { const int hp = task >> 4, k0 = (task & 15) * 64, h = hp >> 1, pp = hp & 1;
                const float* kb = L.peer_keys + (size_t)(pp * 8 + h) * 128 * 128; const float* wb = L.peer_wq + (size_t)k0 * 2048 + hp * 128;
                __syncthreads();
                for (int i = tid; i < 128 * 32; i += NTHREADS) { const int key = i & 127, d4 = (i >> 7) * 4; const f32x4 v = *(const f32x4*)(kb + (size_t)key * 128 + d4);
                    Ks[(d4 + 0) * 128 + key] = v[0]; Ks[(d4 + 1) * 128 + key] = v[1]; Ks[(d4 + 2) * 128 + key] = v[2]; Ks[(d4 + 3) * 128 + key] = v[3]; }
                for (int i = tid; i < 64 * 32; i += NTHREADS) { const int kk = i & 63, d4 = (i >> 6) * 4; const f32x4 v = *(const f32x4*)(wb + (size_t)kk * 2048 + d4);
                    Ws[(d4 + 0) * 64 + kk] = v[0]; Ws[(d4 + 1) * 64 + kk] = v[1]; Ws[(d4 + 2) * 64 + kk] = v[2]; Ws[(d4 + 3) * 64 + kk] = v[3]; }
                __syncthreads();
                float acc[4][4];
#pragma unroll
                for (int i = 0; i < 4; ++i)
#pragma unroll
                    for (int j = 0; j < 4; ++j) acc[i][j] = 0.f;
#pragma unroll 4
                for (int d = 0; d < 128; ++d) { const f32x4 kv = *(const f32x4*)(Ks + d * 128 + 4 * tx), wv = *(const f32x4*)(Ws + d * 64 + 4 * ty);
#pragma unroll
                    for (int i = 0; i < 4; ++i)
#pragma unroll
                        for (int j = 0; j < 4; ++j) acc[i][j] += kv[i] * wv[j]; }
                { const f32x4 gf = *(const f32x4*)(L.ln_ffn + k0 + 4 * ty);
#pragma unroll
                for (int i = 0; i < 4; ++i) { unsigned* o = (unsigned*)(we + (size_t)(hp * 128 + 4 * tx + i) * D_ + k0 + 4 * ty); o[0] = pk2bf(acc[i][0] * gf[0], acc[i][1] * gf[1]); o[1] = pk2bf(acc[i][2] * gf[2], acc[i][3] * gf[3]); } }
            }
            __syncthreads();
        }
#endif
#ifdef EMU
        { EpiKXh e{WSP(bf16_t, WS_KX)}; gemm_bf16(c, WSP(bf16_t, WS_HM), D_, WSP(bf16_t, WS_WT_XK), NMEM, D_, D_, e); }
        { EpiVXT e{WSP(bf16_t, WS_VX)}; gemm_bf16(c, WSP(bf16_t, WS_HM), D_, WSP(bf16_t, WS_WT_XV), NMEM, D_, D_, e); }
#endif
#ifdef EMU
        { EpiInProj e{P, WSP(float, WS_LOGF), WSP(float, WS_LB) + l * 512, pos, SS + (size_t)(3 * l) * T * SSW}; gemm_bf16(c, HB, D_, WSP(bf16_t, WS_WT_IN), T, NIN, D_, e); }
#else
        { static_assert(WS_WT_XV == WS_WT_XK + (size_t)D_ * D_ * 2, "w_xk and w_xv copies must be adjacent: the rider units see them as one [2048][1024] matrix");
          pg8::Gemm g{HB, WSP(bf16_t, WS_WT_IN), T, NIN, D_, D_, 0, (size_t)((const char*)WSP(bf16_t, WS_HM) - (const char*)HB), (size_t)((const char*)WSP(bf16_t, WS_WT_XK) - (const char*)WSP(bf16_t, WS_WT_IN))};
          pg8::PlusOrder S; S.init(T, NIN, c.nb, c.bid, 8); prep_rstd(c, SS + (size_t)(3 * l) * T * SSW, WSP(float, WS_RS) + (size_t)(3 * l) * T, S.base);
          EpiInProjPg8 e{P, WSP(float, WS_LOGF), WSP(float, WS_LB) + l * 512, pos, WSP(float, WS_RS) + (size_t)(3 * l) * T, WSP(bf16_t, WS_KX), WSP(bf16_t, WS_VX)};
          pg8::gemm_phase<EpiInProjPg8, pg8::PlusOrder, true, true>((PG8_LAS unsigned char*)g_lds, g, S, e, c.tid); __syncthreads(); }
#endif
    } break;
    case 2: {
        const int NC = T / 64; const float* lgf = WSP(float, WS_LOGF);
        bf16_t* KT = (bf16_t*)p.out; bf16_t* VT = WSP(bf16_t, WS_VT); float* VEC = WSP(float, WS_VEC);
        for (long w = c.gtid; w < (long)8 * NC * 64; w += c.gsize) {
            const int u = (int)(w >> 6), lane = (int)(w & 63); const int bh = u / NC, cc = u % NC, br = bh >> 2, h = bh & 3; const int t0 = cc * 64, col = 2 * lane;
            const int qcol = (br ? C_RQ : C_HQ) + h * 128 + col, kcol = (br ? C_RK : C_HF) + h * 128 + col, vcol = (br ? C_RV : C_HI) + h * 128 + col;
            const float lgam = logf(1.0f - exp2f(-5.0f - (float)h));
            float b0, b1, last0, last1;
            if (br == 0) { float s0 = 0.f, s1 = 0.f; b0 = 0.f; b1 = 0.f;
#pragma unroll 1
                for (int j0 = 0; j0 < 64; j0 += 16) { float lv0[16], lv1[16];
#pragma unroll
                    for (int jj = 0; jj < 16; ++jj) { const float* lf = lgf + (size_t)(t0 + j0 + jj) * 512 + h * 128 + col; lv0[jj] = lf[0]; lv1[jj] = lf[1]; }
#pragma unroll
                    for (int jj = 0; jj < 16; ++jj) { s0 += lv0[jj]; s1 += lv1[jj]; if (j0 + jj == 31) { b0 = s0; b1 = s1; } } }
                last0 = s0; last1 = s1; }
            else { b0 = b1 = 32.0f * lgam; last0 = last1 = 64.0f * lgam; }
            float s0 = 0.f, s1 = 0.f;
            float lA0[8], lA1[8], lB0[8], lB1[8]; unsigned qA[8], kA[8], vA[8], qB[8], kB[8], vB[8];
#ifdef EMU
#define PREP_VLOAD(dst, r) dst = *(const unsigned*)(P + PI(r, vcol));
#define PREP_EXP(x) expf(x)
#define PREP_PK(a, b) ((unsigned)f2bf(a) | ((unsigned)f2bf(b) << 16))
#else
#define PREP_VLOAD(dst, r)
#define PREP_EXP(x) __expf(x)
#define PREP_PK(a, b) pk2bf(a, b)
#endif
#define PREP_LOAD(L0, L1, Q, K, V, g) { const float* lfb = lgf + (size_t)(t0 + 8 * (g)) * 512 + h * 128 + col; const int r0_ = t0 + 8 * (g); \
                _Pragma("unroll") for (int jj = 0; jj < 8; ++jj) { if (br == 0) { L0[jj] = lfb[jj * 512]; L1[jj] = lfb[jj * 512 + 1]; } \
                    Q[jj] = *(const unsigned*)(P + PI(r0_ + jj, qcol)); K[jj] = *(const unsigned*)(P + PI(r0_ + jj, kcol)); PREP_VLOAD(V[jj], r0_ + jj) } }
#ifdef EMU
#define PREP_PROC(L0, L1, Q, K, V, g) { const int r0_ = t0 + 8 * (g); unsigned ka[4], kb[4], va[4], vb2[4]; \
                _Pragma("unroll") for (int jj = 0; jj < 8; ++jj) { float c0, c1; \
                    if (br == 0) { s0 += L0[jj]; s1 += L1[jj]; c0 = s0; c1 = s1; } else { c0 = c1 = (float)(8 * (g) + jj + 1) * lgam; } \
                    const float q0 = bf2f((bf16_t)(Q[jj] & 0xffffu)) * PREP_EXP(c0 - b0), q1 = bf2f((bf16_t)(Q[jj] >> 16)) * PREP_EXP(c1 - b1); \
                    const unsigned kw = PREP_PK(bf2f((bf16_t)(K[jj] & 0xffffu)) * PREP_EXP(b0 - c0), bf2f((bf16_t)(K[jj] >> 16)) * PREP_EXP(b1 - c1)); \
                    if (!dry) { *(unsigned*)(P + PI(r0_ + jj, qcol)) = PREP_PK(q0, q1); *(unsigned*)(P + PI(r0_ + jj, kcol)) = kw; } \
                    if (jj & 1) { ka[jj >> 1] |= kw << 16; kb[jj >> 1] |= kw & 0xffff0000u; va[jj >> 1] |= V[jj] << 16; vb2[jj >> 1] |= V[jj] & 0xffff0000u; } \
                    else { ka[jj >> 1] = kw & 0xffffu; kb[jj >> 1] = kw >> 16; va[jj >> 1] = V[jj] & 0xffffu; vb2[jj >> 1] = V[jj] >> 16; } } \
                unsigned* d0 = (unsigned*)(KT + ((size_t)u * 128 + col) * 64 + 8 * (g)); unsigned* e0 = (unsigned*)(VT + ((size_t)u * 128 + col) * 64 + 8 * (g)); \
                _Pragma("unroll") for (int i = 0; i < 4; ++i) { d0[i] = ka[i]; d0[32 + i] = kb[i]; e0[i] = va[i]; e0[32 + i] = vb2[i]; } }
#else
#define PREP_PROC(L0, L1, Q, K, V, g) { const int r0_ = t0 + 8 * (g); \
                _Pragma("unroll") for (int jj = 0; jj < 8; ++jj) { float c0, c1; \
                    if (br == 0) { s0 += L0[jj]; s1 += L1[jj]; c0 = s0; c1 = s1; } else { c0 = c1 = (float)(8 * (g) + jj + 1) * lgam; } \
                    const float q0 = bf2f((bf16_t)(Q[jj] & 0xffffu)) * PREP_EXP(c0 - b0), q1 = bf2f((bf16_t)(Q[jj] >> 16)) * PREP_EXP(c1 - b1); \
                    const unsigned kw = PREP_PK(bf2f((bf16_t)(K[jj] & 0xffffu)) * PREP_EXP(b0 - c0), bf2f((bf16_t)(K[jj] >> 16)) * PREP_EXP(b1 - c1)); \
                    if (!dry) { *(unsigned*)(P + PI(r0_ + jj, qcol)) = PREP_PK(q0, q1); *(unsigned*)(P + PI(r0_ + jj, kcol)) = kw; } \
                    wk[(8 * (g) + jj) * 64 + lane] = kw; } }
#endif
#ifndef EMU
            unsigned* wk = (unsigned*)(g_lds + (c.tid >> 6) * 16384);
#endif
            PREP_LOAD(lA0, lA1, qA, kA, vA, 0)
#pragma unroll 1
            for (int g = 0; g < 8; g += 2) {
                PREP_LOAD(lB0, lB1, qB, kB, vB, g + 1)
                PREP_PROC(lA0, lA1, qA, kA, vA, g)
                if (g + 2 < 8) PREP_LOAD(lA0, lA1, qA, kA, vA, g + 2)
                PREP_PROC(lB0, lB1, qB, kB, vB, g + 1)
            }
#undef PREP_LOAD
#undef PREP_PROC
#undef PREP_VLOAD
#ifndef EMU
            { bf16_t* dstT = KT + ((size_t)u * 128 + col) * 64;
#pragma unroll
              for (int g2 = 0; g2 < 8; ++g2) { u32x4 lo, hi;
#pragma unroll
                  for (int i = 0; i < 4; ++i) { const unsigned w0 = wk[(8 * g2 + 2 * i) * 64 + lane], w1 = wk[(8 * g2 + 2 * i + 1) * 64 + lane]; lo[i] = (w0 & 0xffffu) | (w1 << 16); hi[i] = (w0 >> 16) | (w1 & 0xffff0000u); }
                  *(u32x4*)(dstT + 8 * g2) = lo; *(u32x4*)(dstT + 64 + 8 * g2) = hi; } }
            { unsigned vw[64];
#pragma unroll
              for (int j = 0; j < 64; ++j) vw[j] = *(const unsigned*)(P + PI(t0 + j, vcol));
              bf16_t* dstT = VT + ((size_t)u * 128 + col) * 64;
#pragma unroll
              for (int g2 = 0; g2 < 8; ++g2) { u32x4 lo, hi;
#pragma unroll
                  for (int i = 0; i < 4; ++i) { const unsigned w0 = vw[8 * g2 + 2 * i], w1 = vw[8 * g2 + 2 * i + 1]; lo[i] = (w0 & 0xffffu) | (w1 << 16); hi[i] = (w0 >> 16) | (w1 & 0xffff0000u); }
                  *(u32x4*)(dstT + 8 * g2) = lo; *(u32x4*)(dstT + 64 + 8 * g2) = hi; } }
#endif
#undef PREP_EXP
#undef PREP_PK
            float* vb = VEC + (size_t)u * 384; vb[2 * col] = expf(last0); vb[2 * col + 1] = expf(b0); vb[2 * col + 2] = expf(last1); vb[2 * col + 3] = expf(b1); vb[256 + col] = expf(last0 - b0); vb[256 + col + 1] = expf(last1 - b1);
        }
#ifdef EMU
        for (long w = c.gtid; w < (long)T * 8; w += c.gsize) {
            const int t = (int)(w >> 3), h = (int)(w & 7), kvh = h >> 2; float q[64], acc[64];
#pragma unroll
            for (int d = 0; d < 64; ++d) { q[d] = bf2f(P[PI(t, C_SQ + h * 64 + d)]); acc[d] = 0.f; }
            float m = L.sinks[h], lsum = 1.0f;
            const int s0 = t - 127 > 0 ? t - 127 : 0;
            for (int s2 = s0; s2 <= t; ++s2) { const bf16_t* kr = P + PI(s2, C_SK + kvh * 64); const bf16_t* vr = P + PI(s2, C_SV + kvh * 64); float sc = 0.f;
#pragma unroll
                for (int d = 0; d < 64; ++d) sc += q[d] * bf2f(kr[d]);
                const float mn = fmaxf(m, sc), al = expf(m - mn), pe = expf(sc - mn); lsum = lsum * al + pe; m = mn;
#pragma unroll
                for (int d = 0; d < 64; ++d) acc[d] = acc[d] * al + pe * bf2f(vr[d]); }
            const float inv = 1.0f / lsum;
#pragma unroll
            for (int d = 0; d < 64; ++d) OBUF[(size_t)t * 1536 + 1024 + h * 64 + d] = f2bf(acc[d] * inv);
        }
#else
        { bf16_t* SVT = WSP(bf16_t, WS_SVT);
          for (long w = c.gtid; w < (long)2 * NC * 64; w += c.gsize) { const int u = (int)(w >> 6), d = (int)(w & 63), kvh = u / NC, t0 = (u % NC) * 64;
              { unsigned sv[64];
#pragma unroll
                for (int j = 0; j < 64; ++j) sv[j] = P[PI(t0 + j, C_SV + kvh * 64 + d)];
#pragma unroll
                for (int g = 0; g < 8; ++g) *(u32x4*)(SVT + ((size_t)kvh * 64 + d) * T + t0 + 8 * g) = (u32x4){sv[8 * g] | (sv[8 * g + 1] << 16), sv[8 * g + 2] | (sv[8 * g + 3] << 16), sv[8 * g + 4] | (sv[8 * g + 5] << 16), sv[8 * g + 6] | (sv[8 * g + 7] << 16)}; } } }
#endif
    } break;
    case 3: {
        const int NC = T / 64; bf16_t* LS = WSP(bf16_t, WS_LS);
        EpiLS e{LS, WSP(float, WS_VEC)};
        gemm_bf16_batched(c, WSP(bf16_t, WS_VT), 64, (const bf16_t*)p.out, 128, 128, 64, 8 * NC, (size_t)128 * 64, (size_t)128 * 64, e);
#ifndef EMU
        {
            const bf16_t* SVT = WSP(bf16_t, WS_SVT); const int lane = c.tid & 63, fr = lane & 15, fq = lane >> 4, gw = c.gtid >> 6, nw = c.gsize >> 6;
            typedef short s16x4 __attribute__((ext_vector_type(4)));
            for (int wt = gw; wt < 2 * (T / 16); wt += nw) { const int g = wt & 1, t0 = (wt >> 1) * 16, kb = t0 - 128;
                bf16x8 kf[9][2];
#pragma unroll
                for (int kt = 0; kt < 9; ++kt) { int srow = kb + 16 * kt + fr; srow = srow < 0 ? 0 : srow;
#pragma unroll
                    for (int ks = 0; ks < 2; ++ks) kf[kt][ks] = *(const bf16x8*)(P + PI(srow, C_SK + g * 64 + 32 * ks + 8 * fq)); }
#pragma unroll 1
                for (int qh = 0; qh < 4; ++qh) { const int h = 4 * g + qh; const float sink = L.sinks[h];
                    bf16x8 qf[2];
#pragma unroll
                    for (int ks = 0; ks < 2; ++ks) qf[ks] = *(const bf16x8*)(P + PI(t0 + fr, C_SQ + h * 64 + 32 * ks + 8 * fq));
                    f32x4 st[9]; float m = sink;
#pragma unroll
                    for (int kt = 0; kt < 9; ++kt) { st[kt] = (f32x4){0.f, 0.f, 0.f, 0.f};
#pragma unroll
                        for (int ks = 0; ks < 2; ++ks) st[kt] = __builtin_amdgcn_mfma_f32_16x16x32_bf16(kf[kt][ks], qf[ks], st[kt], 0, 0, 0);
#pragma unroll
                        for (int r = 0; r < 4; ++r) { const int srow = kb + 16 * kt + 4 * fq + r, rel = t0 + fr - srow; const bool ok = (srow >= 0) && (rel >= 0) && (rel < 128);
                            st[kt][r] = ok ? st[kt][r] : -1e30f; m = fmaxf(m, st[kt][r]); } }
                    m = fmaxf(m, shx<16>(m)); m = max32(m);
                    float lsum = 0.f;
#pragma unroll
                    for (int kt = 0; kt < 9; ++kt)
#pragma unroll
                        for (int r = 0; r < 4; ++r) { const float pe = __expf(st[kt][r] - m); st[kt][r] = pe; lsum += pe; }
                    lsum += shx<16>(lsum); lsum = add32(lsum); lsum += __expf(sink - m);
                    const float inv = 1.0f / lsum;
                    bf16x8 pf[5];
#pragma unroll
                    for (int pp = 0; pp < 5; ++pp) { bf16x8 f;
#pragma unroll
                        for (int e2 = 0; e2 < 8; ++e2) { const int kt = 2 * pp + (e2 >> 2); f[e2] = (kt < 9) ? (short)f2bf(st[kt < 9 ? kt : 0][e2 & 3]) : (short)0; }
                        pf[pp] = f; }
#pragma unroll
                    for (int dt = 0; dt < 4; ++dt) { f32x4 oacc = (f32x4){0.f, 0.f, 0.f, 0.f}; const bf16_t* vrow = SVT + ((size_t)g * 64 + 16 * dt + fr) * T;
#pragma unroll
                        for (int pp = 0; pp < 5; ++pp) { int s8 = kb + 32 * pp + 4 * fq; const int sa = s8 < 0 ? 0 : s8; const s16x4 lo = *(const s16x4*)(vrow + sa); s16x4 hi = (s16x4){0, 0, 0, 0};
                            if (pp < 4) { const int sb = s8 + 16 < 0 ? 0 : s8 + 16; hi = *(const s16x4*)(vrow + sb); }
                            bf16x8 vf; vf[0] = lo[0]; vf[1] = lo[1]; vf[2] = lo[2]; vf[3] = lo[3]; vf[4] = hi[0]; vf[5] = hi[1]; vf[6] = hi[2]; vf[7] = hi[3];
                            oacc = __builtin_amdgcn_mfma_f32_16x16x32_bf16(vf, pf[pp], oacc, 0, 0, 0); }
                        unsigned* dst = (unsigned*)(OBUF + (size_t)(t0 + fr) * 1536 + 1024 + h * 64 + 16 * dt + 4 * fq);
                        dst[0] = pk2bf(oacc[0] * inv, oacc[1] * inv); dst[1] = pk2bf(oacc[2] * inv, oacc[3] * inv); }
                }
            }
        }
#endif
    } break;
    case 4: {
        const int NC = T / 64; bf16_t* LS = WSP(bf16_t, WS_LS); const float* VEC = WSP(float, WS_VEC);
        { constexpr int UB = (T_ / 64) % 32 == 0 ? 16 : 2; struct f32x4s { float x, y, z, w; };
#ifdef EMU
          const long e_lo = c.gtid, e_step = c.gsize;
#else
          const long e_lo = (c.tid < 256) ? (long)c.bid * 256 + c.tid : (1L << 40), e_step = (long)c.nb * 256;
#endif
          for (long e = e_lo; e < 8L * 128 * 64; e += e_step) { const int kp = (int)(e & 63), vv = (int)((e >> 6) & 127), bh = (int)(e >> 13); float st0 = 0.f, st1 = 0.f;
            unsigned lvA[UB], lvB[UB]; f32x4s vA[UB], vB[UB];
#define SCAN_LOAD(lv, vv4, cb0) _Pragma("unroll") for (int i = 0; i < UB; ++i) { const int u = bh * NC + (cb0) + i; lv[i] = *((const unsigned*)(LS + ((size_t)u * 128 + vv) * 128) + kp); vv4[i] = *(const f32x4s*)(VEC + (size_t)u * 384 + 4 * kp); }
#define SCAN_PROC(lv, vv4, cb0) _Pragma("unroll") for (int i = 0; i < UB; ++i) { const int u = bh * NC + (cb0) + i; unsigned* ls = (unsigned*)(LS + ((size_t)u * 128 + vv) * 128) + kp; \
                if (!dry) *ls = (unsigned)f2bf(vv4[i].y * st0) | ((unsigned)f2bf(vv4[i].w * st1) << 16); \
                st0 = vv4[i].x * st0 + bf2f((bf16_t)(lv[i] & 0xffffu)); st1 = vv4[i].z * st1 + bf2f((bf16_t)(lv[i] >> 16)); }
            SCAN_LOAD(lvA, vA, 0)
#pragma unroll 1
            for (int cb = 0; cb < NC; cb += 2 * UB) {
                if (cb + UB < NC) { SCAN_LOAD(lvB, vB, cb + UB) }
                SCAN_PROC(lvA, vA, cb)
                if (cb + 2 * UB < NC) { SCAN_LOAD(lvA, vA, cb + 2 * UB) }
                if (cb + UB < NC) { SCAN_PROC(lvB, vB, cb + UB) }
            }
#undef SCAN_LOAD
#undef SCAN_PROC
            if (dry && st0 + st1 == 12345.678f) LS[0] = 0; } }
        unsigned char* tu = WSP(unsigned char, WS_TABU); unsigned char* tv = WSP(unsigned char, WS_TABV);
#ifdef EMU
#if PEER_FP4
        for (long i = c.gtid; i < 16384L * D_ / 2; i += c.gsize) { const long e0 = 2 * i; tu[i] = (unsigned char)(f2fp4_sw(L.peer_u[e0] * L.ln_ffn[e0 & 1023] * PEER_U_SCALE) | (f2fp4_sw(L.peer_u[e0 + 1] * L.ln_ffn[(e0 + 1) & 1023] * PEER_U_SCALE) << 4));
            tv[i] = (unsigned char)(f2fp4_sw(L.peer_v[e0] * PEER_V_SCALE) | (f2fp4_sw(L.peer_v[e0 + 1] * PEER_V_SCALE) << 4)); }
#else
        for (long i = c.gtid; i < 16384L * D_; i += c.gsize) { tu[i] = f2fp8_sw(L.peer_u[i] * L.ln_ffn[i & 1023] * PEER_U_SCALE); tv[i] = f2fp8_sw(L.peer_v[i] * PEER_V_SCALE); }
#endif
#else
#if PEER_FP4
        {
            const int lane = c.tid & 63, wv = c.tid >> 6, gw = c.gtid >> 6, nw = c.gsize >> 6; unsigned char* wl = g_lds + wv * 1024;
            f32x4 gf[4];
#pragma unroll
            for (int k = 0; k < 4; ++k) gf[k] = ((const f32x4*)L.ln_ffn)[64 * k + lane] * PEER_U_SCALE;
            for (int row = gw; row < 16384; row += nw) { const f32x4* ur = (const f32x4*)(L.peer_u + (size_t)row * D_); const f32x4* vr = (const f32x4*)(L.peer_v + (size_t)row * D_); f32x4 a[4], b[4];
#pragma unroll
                for (int k = 0; k < 4; ++k) { a[k] = ur[64 * k + lane]; b[k] = vr[64 * k + lane]; }
#pragma unroll
                for (int k = 0; k < 4; ++k) { a[k] = a[k] * gf[k]; b[k] = b[k] * PEER_V_SCALE; unsigned x = 0, y = 0;
                    x = __builtin_amdgcn_cvt_scalef32_pk_fp4_f32(x, a[k][0], a[k][1], 1.0f, 0); x = __builtin_amdgcn_cvt_scalef32_pk_fp4_f32(x, a[k][2], a[k][3], 1.0f, 1);
                    y = __builtin_amdgcn_cvt_scalef32_pk_fp4_f32(y, b[k][0], b[k][1], 1.0f, 0); y = __builtin_amdgcn_cvt_scalef32_pk_fp4_f32(y, b[k][2], b[k][3], 1.0f, 1);
                    *(unsigned short*)(wl + 128 * k + 2 * lane) = (unsigned short)x; *(unsigned short*)(wl + 512 + 128 * k + 2 * lane) = (unsigned short)y; }
                asm volatile("" ::: "memory");
                const unsigned long long ou = *(const unsigned long long*)(wl + 8 * lane), ov = *(const unsigned long long*)(wl + 512 + 8 * lane);
                asm volatile("" ::: "memory");
                ((unsigned long long*)(tu + (size_t)row * PEER_ROWB))[lane] = ou; ((unsigned long long*)(tv + (size_t)row * PEER_ROWB))[lane] = ov; }
            __syncthreads();
        }
#else
        for (long i = c.gtid; i < 16384L * D_ / 16; i += c.gsize) {
            f32x4 a[4], b[4];
#pragma unroll
            for (int k = 0; k < 4; ++k) { a[k] = ((const f32x4*)L.peer_u)[4 * i + k] * ((const f32x4*)L.ln_ffn)[(4 * i + k) & 255] * PEER_U_SCALE; b[k] = ((const f32x4*)L.peer_v)[4 * i + k] * PEER_V_SCALE; }
#if PEER_FP4
            unsigned wu[2], wv[2];
#pragma unroll
            for (int hh = 0; hh < 2; ++hh) { unsigned x = 0, y = 0;
                x = __builtin_amdgcn_cvt_scalef32_pk_fp4_f32(x, a[2 * hh][0], a[2 * hh][1], 1.0f, 0); x = __builtin_amdgcn_cvt_scalef32_pk_fp4_f32(x, a[2 * hh][2], a[2 * hh][3], 1.0f, 1);
                x = __builtin_amdgcn_cvt_scalef32_pk_fp4_f32(x, a[2 * hh + 1][0], a[2 * hh + 1][1], 1.0f, 2); x = __builtin_amdgcn_cvt_scalef32_pk_fp4_f32(x, a[2 * hh + 1][2], a[2 * hh + 1][3], 1.0f, 3);
                y = __builtin_amdgcn_cvt_scalef32_pk_fp4_f32(y, b[2 * hh][0], b[2 * hh][1], 1.0f, 0); y = __builtin_amdgcn_cvt_scalef32_pk_fp4_f32(y, b[2 * hh][2], b[2 * hh][3], 1.0f, 1);
                y = __builtin_amdgcn_cvt_scalef32_pk_fp4_f32(y, b[2 * hh + 1][0], b[2 * hh + 1][1], 1.0f, 2); y = __builtin_amdgcn_cvt_scalef32_pk_fp4_f32(y, b[2 * hh + 1][2], b[2 * hh + 1][3], 1.0f, 3);
                wu[hh] = x; wv[hh] = y; }
            ((unsigned long long*)tu)[i] = (unsigned long long)wu[0] | ((unsigned long long)wu[1] << 32); ((unsigned long long*)tv)[i] = (unsigned long long)wv[0] | ((unsigned long long)wv[1] << 32);
#else
            u32x4 wu, wv;
#pragma unroll
            for (int k = 0; k < 4; ++k) { int x = 0; x = __builtin_amdgcn_cvt_pk_fp8_f32(a[k][0], a[k][1], x, false); x = __builtin_amdgcn_cvt_pk_fp8_f32(a[k][2], a[k][3], x, true); wu[k] = (unsigned)x;
                int y = 0; y = __builtin_amdgcn_cvt_pk_fp8_f32(b[k][0], b[k][1], y, false); y = __builtin_amdgcn_cvt_pk_fp8_f32(b[k][2], b[k][3], y, true); wv[k] = (unsigned)y; }
            ((u32x4*)tu)[i] = wu; ((u32x4*)tv)[i] = wv;
#endif
        }
#endif
#endif
    } break;
    case 5: {
        const int NC = T / 64; const bf16_t* LS = WSP(bf16_t, WS_LS); const bf16_t* VT = WSP(bf16_t, WS_VT); bf16_t* OR = ((bf16_t*)p.out + (size_t)T * D_);
#ifdef EMU
        for (long w = c.gtid; w < (long)8 * NC * 64; w += c.gsize) { const int u = (int)(w >> 6), i = (int)(w & 63); const int bh = u / NC, cc = u % NC, br = bh >> 2, h = bh & 3, t0 = cc * 64;
            const int qcol = (br ? C_RQ : C_HQ) + h * 128, kcol = (br ? C_RK : C_HF) + h * 128; const bf16_t* qr = P + PI(t0 + i, qcol); float sc[64];
            for (int j = 0; j <= i; ++j) { const bf16_t* kr = P + PI(t0 + j, kcol); float a = 0.f; for (int k = 0; k < 128; ++k) a += bf2f(qr[k]) * bf2f(kr[k]); sc[j] = bf2f(f2bf(a)); }
            for (int vv = 0; vv < 128; ++vv) { float o = 0.f; const bf16_t* sr = LS + ((size_t)u * 128 + vv) * 128; for (int k = 0; k < 128; ++k) o += bf2f(qr[k]) * bf2f(sr[k]);
                const bf16_t* vr = VT + ((size_t)u * 128 + vv) * 64; for (int j = 0; j <= i; ++j) o += sc[j] * bf2f(vr[j]);
                OR[(size_t)(t0 + i) * 1024 + br * 512 + h * 128 + vv] = f2bf(o); } }
#else
        const int lane = c.tid & 63, fr = lane & 15, fq = lane >> 4; const int gw = c.gtid >> 6, nw = c.gsize >> 6;
        for (int wt = gw; wt < 8 * NC; wt += nw) { const int u = wt; const int bh = u / NC, cc = u % NC, br = bh >> 2, h = bh & 3, t0     = cc * 64;
            const int qcol = (br ? C_RQ : C_HQ) + h * 128, kcol = (br ? C_RK : C_HF) + h * 128;
            bf16x8 qf[4][4];
#pragma unroll
            for (int I = 0; I < 4; ++I)
#pragma unroll
                for (int ks = 0; ks < 4; ++ks) qf[I][ks] = *(const bf16x8*)(P + PI(t0 + 16 * I + fr, qcol + 32 * ks + 8 * fq));
            f32x4 st[10];
#pragma unroll
            for (int i = 0; i < 10; ++i) st[i] = (f32x4){0.f, 0.f, 0.f, 0.f};
#pragma unroll
            for (int ks = 0; ks < 4; ++ks) { bf16x8 kf[4];
#pragma unroll
                for (int J = 0; J < 4; ++J) kf[J] = *(const bf16x8*)(P + PI(t0 + 16 * J + fr, kcol + 32 * ks + 8 * fq));
#pragma unroll
                for (int I = 0; I < 4; ++I)
#pragma unroll
                    for (int J = 0; J <= I; ++J) st[I * (I + 1) / 2 + J] = __builtin_amdgcn_mfma_f32_16x16x32_bf16(kf[J], qf[I][ks], st[I * (I + 1) / 2 + J], 0, 0, 0); }
#pragma unroll
            for (int I = 0; I < 4; ++I)
#pragma unroll
                for (int r = 0; r < 4; ++r) if (4 * fq + r > fr) st[I * (I + 1) / 2 + I][r] = 0.f;
            bf16x8 pf[4][2];
#pragma unroll
            for (int I = 0; I < 4; ++I)
#pragma unroll
                for (int pp = 0; pp < 2; ++pp) { bf16x8 f;
#pragma unroll
                    for (int e2 = 0; e2 < 8; ++e2) { const int J = 2 * pp + (e2 >> 2); f[e2] = (J <= I) ? (short)f2bf(st[I * (I + 1) / 2 + (J <= I ? J : 0)][e2 & 3]) : (short)0; }
                    pf[I][pp] = f; }
#pragma unroll 2
            for (int vt = 0; vt < 8; ++vt) { f32x4 oacc[4];
#pragma unroll
                for (int I = 0; I < 4; ++I) oacc[I] = (f32x4){0.f, 0.f, 0.f, 0.f};
#pragma unroll
                for (int ks = 0; ks < 4; ++ks) { const bf16x8 sf = *(const bf16x8*)(LS + ((size_t)u * 128 + 16 * vt + fr) * 128 + 32 * ks + 8 * fq);
#pragma unroll
                    for (int I = 0; I < 4; ++I) oacc[I] = __builtin_amdgcn_mfma_f32_16x16x32_bf16(sf, qf[I][ks], oacc[I], 0, 0, 0); }
#pragma unroll
                for (int pp = 0; pp < 2; ++pp) { const bf16_t* vb = VT + ((size_t)u * 128 + 16 * vt + fr) * 64 + 32 * pp + 4 * fq;
                    typedef short s16x4 __attribute__((ext_vector_type(4)));
                    const s16x4 lo = *(const s16x4*)vb, hi = *(const s16x4*)(vb + 16); bf16x8 vf; vf[0] = lo[0]; vf[1] = lo[1]; vf[2] = lo[2]; vf[3] = lo[3]; vf[4] = hi[0]; vf[5] = hi[1]; vf[6] = hi[2]; vf[7] = hi[3];
#pragma unroll
                    for (int I = 0; I < 4; ++I) if (2 * pp <= I) oacc[I] = __builtin_amdgcn_mfma_f32_16x16x32_bf16(vf, pf[I][pp], oacc[I], 0, 0, 0); }
#pragma unroll
                for (int I = 0; I < 4; ++I) { unsigned* dst = (unsigned*)(OR + (size_t)(t0 + 16 * I + fr) * 1024 + br * 512 + h * 128 + 16 * vt + 4 * fq);
                    dst[0] = (unsigned)f2bf(oacc[I][0]) | ((unsigned)f2bf(oacc[I][1]) << 16); dst[1] = (unsigned)f2bf(oacc[I][2]) | ((unsigned)f2bf(oacc[I][3]) << 16); }
            }
        }
#endif
    } break;
    case 6: {
#ifdef EMU
        const bf16_t* oraw = ((bf16_t*)p.out + (size_t)T * D_);
        for (int r = c.gtid; r < T; r += c.gsize) { const bf16_t* orow = oraw + (size_t)r * D_; float ss = 0.f; for (int i = 0; i < 512; ++i) ss += bf2f(orow[i]) * bf2f(orow[i]);
            const float rs = 1.0f / sqrtf(ss * (1.0f / 512.0f) + 1e-6f);
            for (int i = 0; i < 512; ++i) OBUF[(size_t)r * 1536 + i] = f2bf(bf2f(orow[i]) * rs * L.hgrn_norm[i] * bf2f(P[PI(r, C_HG + i)])); }
        for (long w = c.gtid; w < (long)T * 4; w += c.gsize) { const int r = (int)(w >> 2), h = (int)(w & 3); const bf16_t* orow = oraw + (size_t)r * D_ + 512 + h * 128; float ss = 0.f;
            for (int i = 0; i < 128; ++i) ss += bf2f(orow[i]) * bf2f(orow[i]);
            const float rs = 1.0f / sqrtf(ss * (1.0f / 128.0f) + 1e-6f);
            for (int i = 0; i < 128; ++i) OBUF[(size_t)r * 1536 + 512 + h * 128 + i] = f2bf(bf2f(orow[i]) * rs * bf2f(P[PI(r, C_RG + h * 128 + i)])); }
    #else
        { const bf16_t* oraw = ((bf16_t*)p.out + (size_t)T * D_); const int lane = c.tid & 63, gw = c.gtid >> 6, nw = c.gsize >> 6;
          for (int r = gw; r < T; r += nw) {
              const u32x4 a = *(const u32x4*)(oraw + (size_t)r * D_ + 8 * lane), b = *(const u32x4*)(oraw + (size_t)r * D_ + 512 + 8 * lane);
              const u32x4 ga = *(const u32x4*)(P + PI(r, C_HG + 8 * lane)), gb = *(const u32x4*)(P + PI(r, C_RG + 8 * lane));
              float av[8], bv[8]; float sa = 0.f, sb = 0.f;
#pragma unroll
              for (int i = 0; i < 4; ++i) { av[2 * i] = bf2f((bf16_t)(a[i] & 0xffffu)); av[2 * i + 1] = bf2f((bf16_t)(a[i] >> 16)); bv[2 * i] = bf2f((bf16_t)(b[i] & 0xffffu)); bv[2 * i + 1] = bf2f((bf16_t)(b[i] >> 16)); }
#pragma unroll
              for (int i = 0; i < 8; ++i) { sa += av[i] * av[i]; sb += bv[i] * bv[i]; }
              sa = wave_sum(sa); sb += shx<1>(sb); sb += shx<2>(sb); sb += shx<4>(sb); sb += shx<8>(sb);
              const float ra = 1.0f / sqrtf(sa * (1.0f / 512.0f) + 1e-6f), rb = 1.0f / sqrtf(sb * (1.0f / 128.0f) + 1e-6f);
              const f32x4 n0 = ((const f32x4*)(L.hgrn_norm + 8 * lane))[0], n1 = ((const f32x4*)(L.hgrn_norm + 8 * lane))[1];
              u32x4 oa, ob;
#pragma unroll
              for (int i = 0; i < 4; ++i) { const float g0 = bf2f((bf16_t)(ga[i] & 0xffffu)), g1 = bf2f((bf16_t)(ga[i] >> 16)), h0 = bf2f((bf16_t)(gb[i] & 0xffffu)), h1 = bf2f((bf16_t)(gb[i] >> 16));
                  const float w0 = (2 * i < 4) ? n0[2 * i] : n1[2 * i - 4], w1 = (2 * i + 1 < 4) ? n0[2 * i + 1] : n1[2 * i + 1 - 4];
                  oa[i] = pk2bf(av[2 * i] * ra * w0 * g0, av[2 * i + 1] * ra * w1 * g1); ob[i] = pk2bf(bv[2 * i] * rb * h0, bv[2 * i + 1] * rb * h1); }
              *(u32x4*)(OBUF + (size_t)r * 1536 + 8 * lane) = oa; *(u32x4*)(OBUF + (size_t)r * 1536 + 512 + 8 * lane) = ob; } }
#endif
    } break;
    case 7: {
#ifdef EMU
        for (int b = 0; b < 3; ++b) { EpiBranch e{b, P, WSP(float, WS_TMPMIX), WSP(bf16_t, WS_MIXB)}; gemm_bf16(c, OBUF + b * 512, 1536, WSP(bf16_t, WS_WT_BR) + (size_t)b * D_ * 512, T, D_, 512, e); }
#else
        { pg8::Gemm g{OBUF, WSP(bf16_t, WS_WT_BR), T, D_, 512, 1536, 0, 1024, (size_t)D_ * 512 * 2}; pg8::ZOrder<3> S; S.init(T, D_, c.nb, c.bid);
          pg8::EpiAdapt8<EpiBranch8> ea{EpiBranch8{P, WSP(bf16_t, WS_TMPMIX), WSP(bf16_t, WS_MIXB)}};
          pg8::gemm_phase<pg8::EpiAdapt8<EpiBranch8>, pg8::ZOrder<3>, true, true>((PG8_LAS unsigned char*)g_lds, g, S, ea, c.tid); __syncthreads(); }
#endif
    } break;
    case 8: {
#ifdef EMU
        { EpiResidual e{HB, SS + (size_t)(3 * l + 1) * T * SSW}; gemm_bf16(c, WSP(bf16_t, WS_MIXB), D_, WSP(bf16_t, WS_WT_OUT), T, D_, D_, e); }
#else
        { pg8::Gemm g{WSP(bf16_t, WS_MIXB), WSP(bf16_t, WS_WT_OUT), T, D_, D_, D_, 0, 0, 0}; pg8::StaticOrder S; S.init(T, D_, c.nb, c.bid);
          EpiResidualPg8 e{HB, dry ? WSP(bf16_t, WS_XSC) : HB, dry ? nullptr : SS + (size_t)(3 * l + 1) * T * SSW};
          pg8::gemm_phase<EpiResidualPg8, pg8::StaticOrder, true, true>((PG8_LAS unsigned char*)g_lds, g, S, e, c.tid); __syncthreads(); }
#endif
    } break;
    case 9: break;
    case 10: { EpiRowScaleBf16 e{WSP(bf16_t, WS_QX), D_, 0.0625f, SS + (size_t)(3 * l + 1) * T * SSW, WSP(float, WS_RS) + (size_t)(3 * l + 1) * T}; gemm_big_r(c, HB, D_, WSP(bf16_t, WS_WT_XQ), T, D_, D_, e); } break;
    case 11: {
#ifdef EMU
        { EpiStoreF32 e{WSP(float, WS_XSC), D_}; gemm_blockdiag(c, WSP(bf16_t, WS_QX), D_, WSP(bf16_t, WS_KX), T, e); }
#else
        { static_assert((T_ / 256) * 4 == 256, "fused softmax epilogue needs exactly one 256x256 unit per workgroup on a 256-CU grid");
          pg8::Gemm g{WSP(bf16_t, WS_QX), WSP(bf16_t, WS_KX), T, 1024, 256, D_, 512, 0, 0}; pg8::StaticOrder S; S.init(T, 1024, c.nb, c.bid); EpiSoftmaxPg8 e{WSP(bf16_t, WS_PX)};
          if (c.nb == 256) { pg8::gemm_phase<EpiSoftmaxPg8, pg8::StaticOrder, false, true>((PG8_LAS unsigned char*)g_lds, g, S, e, c.tid); __syncthreads(); } }
#endif
    } break;
    case 12: {
        const float* xs = WSP(float, WS_XSC); bf16_t* px = WSP(bf16_t, WS_PX);
#ifdef EMU
        for (long w = c.gtid; w < (long)T * 4; w += c.gsize) { const float* r = xs + w * 256; float mx = -1e30f; for (int i = 0; i < 256; ++i) mx = fmaxf(mx, r[i]);
            float sum = 0.f; for (int i = 0; i < 256; ++i) sum += expf(r[i] - mx); const float inv = 1.0f / sum; for (int i = 0; i < 256; ++i) px[w * 256 + i] = f2bf(expf(r[i] - mx) * inv); }
#else
#endif
    } break;
    case 13: { EpiStoreBf16 e{WSP(bf16_t, WS_OX), D_, 1.0f}; gemm_blockdiag(c, WSP(bf16_t, WS_PX), D_, WSP(bf16_t, WS_VX), T, e); } break;
    case 14: {
#ifdef EMU
        { EpiResidual e{HB, SS + (size_t)(3 * l + 2) * T * SSW}; gemm_bf16(c, WSP(bf16_t, WS_OX), D_, WSP(bf16_t, WS_WT_XO), T, D_, D_, e); }
#else
        { pg8::Gemm g{WSP(bf16_t, WS_OX), WSP(bf16_t, WS_WT_XO), T, D_, D_, D_, 0, 0, 0}; pg8::StaticOrder S; S.init(T, D_, c.nb, c.bid);
          EpiResidualPg8 e{HB, dry ? WSP(bf16_t, WS_XSC) : HB, dry ? nullptr : SS + (size_t)(3 * l + 2) * T * SSW};
          pg8::gemm_phase<EpiResidualPg8, pg8::StaticOrder, true, true>((PG8_LAS unsigned char*)g_lds, g, S, e, c.tid); __syncthreads(); }
#endif
    } break;
    case 15: break;
    case 16: { EpiRowScaleF32 e{WSP(float, WS_PSC), 2048, SS + (size_t)(3 * l + 2) * T * SSW, WSP(float, WS_RS) + (size_t)(3 * l + 2) * T}; gemm_big_r(c, HB, D_, WSP(bf16_t, WS_WT_EFF), T, 2048, D_, e); } break;
    case 17: {
        const float* psc = WSP(float, WS_PSC); int* pidx = WSP(int, WS_PIDX); float* pgate = WSP(float, WS_PGATE);
#ifdef EMU
        for (long w = c.gtid; w < (long)T * 8; w += c.gsize) { const int t = (int)(w >> 3), h = (int)(w & 7);
#else
        static_assert((T_ / 256) * 8 == 2 * 256, "two score tiles per workgroup");
        pg8::StaticOrder SO; SO.init(T, 2048, c.nb, c.bid); pg8::Unit uu;
        for (int it_ = 0; it_ < 1; ++it_) { if (!SO.next(c.tid >> 8, uu)) continue; const int t = uu.pm * 256 + (c.tid & 255), h = uu.pn;
#endif
            unsigned top[2][16];
#pragma unroll
            for (int pp = 0; pp < 2; ++pp) { const float* sr = psc + (size_t)t * 2048 + h * 256 + pp * 128;
#ifndef EMU
                float raw[128]; { const bf16_t* tb = (const bf16_t*)psc + ((size_t)(uu.pm * 8 + uu.pn) << 16) + ((size_t)(pp * 128) << 8) + (c.tid & 255);
#pragma unroll
                for (int i = 0; i < 128; ++i) raw[i] = bf2f(tb[i * 256]); }
#endif
#pragma unroll
                for (int g = 0; g < 8; ++g) { unsigned grp[16];
#pragma unroll
                    for (int i = 0; i < 16; ++i) {
#ifdef EMU
                        const float x = sr[16 * g + i];
#else
                        const float x = raw[16 * g + i];
#endif
                        grp[i] = (fkey(x) & ~127u) | (unsigned)(16 * g + i); }
                    bitonic_sort16_desc(grp);
                    if (g == 0) {
#pragma unroll
                        for (int i = 0; i < 16; ++i) top[pp][i] = grp[i]; }
                    else merge_top16(top[pp], grp); } }
            float v0[16], v1[16];
#pragma unroll
            for (int i = 0; i < 16; ++i) { v0[i] = fkey_inv(top[0][i] & ~127u); v1[i] = fkey_inv(top[1][i] & ~127u); }
            unsigned ck[64];
            cand_fill_a<0>(ck, v0, v1);
#pragma unroll
            for (int i = 50; i < 64; ++i) ck[i] = 0u;
            unsigned ct[16], cg[16];
#pragma unroll
            for (int i = 0; i < 16; ++i) ct[i] = ck[i];
            bitonic_sort16_desc(ct);
#pragma unroll
            for (int g = 1; g < 4; ++g) {
#pragma unroll
                for (int i = 0; i < 16; ++i) cg[i] = ck[16 * g + i];
                bitonic_sort16_desc(cg); merge_top16(ct, cg); }
#ifdef EMU
            unsigned char tab[32];
#else
            unsigned char* tab = g_lds + c.tid * 32;
#endif
#pragma unroll
            for (int i = 0; i < 16; ++i) { tab[i] = (unsigned char)(top[0][i] & 127u); tab[16 + i] = (unsigned char)(top[1][i] & 127u); }
            float ev[16], sum = 0.f; const float cmax = fkey_inv(ct[0] & ~255u);
#pragma unroll
            for (int j = 0; j < 16; ++j) { ev[j] = expf(fkey_inv(ct[j] & ~255u) - cmax); sum += ev[j]; }
            const float inv = 1.0f / sum;
#pragma unroll
            for (int j = 0; j < 16; ++j) { const unsigned code = ct[j] & 255u; pidx[(size_t)t * 128 + h * 16 + j] = (int)tab[code >> 4] * 128 + (int)tab[16 + (code & 15u)]; pgate[(size_t)t * 128 + h * 16 + j] = ev[j] * inv; }
        }
#ifndef EMU
        __syncthreads();
#endif
    } break;
    case 18: {
        const int* pidx = WSP(int, WS_PIDX); const float* pgate = WSP(float, WS_PGATE); const unsigned char* tu = WSP(unsigned char, WS_TABU);
#ifdef EMU
        float* coef = WSP(float, WS_COEF);
        for (long w = c.gtid; w < (long)T * 128; w += c.gsize) { const int t = (int)(w >> 7); const unsigned char* ur = tu + (size_t)pidx[w] * PEER_ROWB; const bf16_t* hr = HB + (size_t)t * D_; float sacc = 0.f;
            for (int d = 0; d < D_; ++d) sacc += bf2f(hr[d]) * tab_get_sw(ur, d);
            coef[w] = pgate[w] * geluf_(sacc * row_rstd(SS + (size_t)(3 * l + 2) * T * SSW, t) * (1.0f / PEER_U_SCALE)) * (1.0f / PEER_V_SCALE); }
#else
        {
          const unsigned char* tv = WSP(unsigned char, WS_TABV); const int lane = c.tid & 63, wv = c.tid >> 6, gw = c.gtid >> 6, nw = c.gsize >> 6;
          typedef float f32x2 __attribute__((ext_vector_type(2))); typedef int i32x8 __attribute__((ext_vector_type(8)));
          float* lcoef = (float*)g_lds + wv * 128; unsigned char* wx = g_lds + 8192 + wv * 2048;
          const float* ssn = SS + (size_t)(3 * l + 2) * T * SSW;
          const int c16 = lane & 15, h32 = lane >> 5; const unsigned g16 = (unsigned)(lane >> 4) * 16u, lane8 = (unsigned)lane * 8u, p32 = (unsigned)(lane & 31) * 16u;
          unsigned char* ub = g_lds + 24576 + wv * 9216;
#define PEER_TOKLOAD(t, i0, i1, g0, g1, a, b, r) { const unsigned o = (unsigned)(t) * 128u + (unsigned)lane; i0 = pidx[o]; i1 = pidx[o + 64]; g0 = pgate[o]; g1 = pgate[o + 64]; \
              const u32x4* xr = (const u32x4*)(HB + (size_t)(t) * D_ + lane * 16); a = xr[0]; b = xr[1]; r = row_rstd(ssn, (t)); }
#define PEER_VLOAD(vl, j0) { const int isel = ((j0) < 64) ? idx0 : idx1; _Pragma("unroll") for (int b2 = 0; b2 < 8; ++b2) { const int e = __builtin_amdgcn_readlane(isel, (((j0) & 63) + b2)); vl[b2] = *(const unsigned long long*)((tv + (unsigned)e * PEER_ROWB) + lane8); } }
#define PEER_VPROC(vl, j0) _Pragma("unroll") for (int b2 = 0; b2 < 8; ++b2) { const float cj = lcoef[(j0) + b2]; \
                  _Pragma("unroll") for (int w2 = 0; w2 < 2; ++w2) { const unsigned wd = (unsigned)(vl[b2] >> (32 * w2)); \
                      const f32x2 p0 = __builtin_amdgcn_cvt_scalef32_pk_f32_fp4(wd, 1.0f, 0), p1 = __builtin_amdgcn_cvt_scalef32_pk_f32_fp4(wd, 1.0f, 1), p2 = __builtin_amdgcn_cvt_scalef32_pk_f32_fp4(wd, 1.0f, 2), p3 = __builtin_amdgcn_cvt_scalef32_pk_f32_fp4(wd, 1.0f, 3); \
                      oacc[8 * w2] += cj * p0[0]; oacc[8 * w2 + 1] += cj * p0[1]; oacc[8 * w2 + 2] += cj * p1[0]; oacc[8 * w2 + 3] += cj * p1[1]; \
                      oacc[8 * w2 + 4] += cj * p2[0]; oacc[8 * w2 + 5] += cj * p2[1]; oacc[8 * w2 + 6] += cj * p3[0]; oacc[8 * w2 + 7] += cj * p3[1]; } \
                  asm volatile("" : "+v"(oacc[0]), "+v"(oacc[1]), "+v"(oacc[2]), "+v"(oacc[3]), "+v"(oacc[4]), "+v"(oacc[5]), "+v"(oacc[6]), "+v"(oacc[7]), "+v"(oacc[8]), "+v"(oacc[9]), "+v"(oacc[10]), "+v"(oacc[11]), "+v"(oacc[12]), "+v"(oacc[13]), "+v"(oacc[14]), "+v"(oacc[15])); }
#define PEER_BLOAD(raw, eg) { _Pragma("unroll") for (int m = 0; m < 8; ++m) { const int e = ((eg) < 4) ? bperm_i(idx0, (eg) * 16 + 2 * m + h32) : bperm_i(idx1, ((eg) - 4) * 16 + 2 * m + h32); \
                  raw[m] = *(const u32x4*)(tu + ((unsigned)e * PEER_ROWB + p32)); } }
#define PEER_BPERM(raw, bf) { _Pragma("unroll") for (int m = 0; m < 8; ++m) *(u32x4*)(ub + (2 * m + h32) * 576 + p32) = raw[m]; \
                  _Pragma("unroll") for (int kk = 0; kk < 8; ++kk) bf[kk] = *(const u32x4*)(ub + c16 * 576 + kk * 64 + g16); }
#define PEER_BPROC(bf, eg) { f32x4 dacc = (f32x4){0.f, 0.f, 0.f, 0.f}; \
                  _Pragma("unroll") for (int kk = 0; kk < 8; ++kk) { const i32x8 bb = (i32x8){(int)bf[kk][0], (int)bf[kk][1], (int)bf[kk][2], (int)bf[kk][3], 0, 0, 0, 0}; \
                      dacc = __builtin_amdgcn_mfma_scale_f32_16x16x128_f8f6f4(afr[kk], bb, dacc, 0, 4, 0, 0x7f7f7f7f, 0, 0x7f7f7f7f); } \
                  lcoef[(lane < 16) ? (eg) * 16 + lane : 1024 + wv * 64 + lane - wv * 128] = dacc[0] + dacc[1] * 0.0625f; }
#define SB __builtin_amdgcn_sched_barrier(0);
          int tok = gw; int idx0 = 0, idx1 = 0; float gt0 = 0.f, gt1 = 0.f, rs = 0.f; u32x4 xa = (u32x4){0u, 0u, 0u, 0u}, xc = xa;
          if (tok < T) { PEER_TOKLOAD(tok, idx0, idx1, gt0, gt1, xa, xc, rs) }
          for (; tok < T; tok += nw) {
              unsigned long long vlA[8], vlB[8], vlC[8], vlD[8];
              { u32x4 hi4, lo4;
#pragma unroll
                for (int i = 0; i < 4; ++i) { const unsigned w0 = (i < 2) ? xa[2 * (i & 1)] : xc[2 * (i & 1)], w1 = (i < 2) ? xa[2 * (i & 1) + 1] : xc[2 * (i & 1) + 1];
                    const float f0 = bf2f((bf16_t)(w0 & 0xffffu)) * rs, f1 = __uint_as_float(w0 & 0xffff0000u) * rs, f2 = bf2f((bf16_t)(w1 & 0xffffu)) * rs, f3 = __uint_as_float(w1 & 0xffff0000u) * rs;
                    int h = 0; h = __builtin_amdgcn_cvt_pk_fp8_f32(f0, f1, h, false); h = __builtin_amdgcn_cvt_pk_fp8_f32(f2, f3, h, true);
                    const f32x2 b01 = __builtin_amdgcn_cvt_pk_f32_fp8(h, false), b23 = __builtin_amdgcn_cvt_pk_f32_fp8(h, true);
                    int lo = 0; lo = __builtin_amdgcn_cvt_pk_fp8_f32((f0 - b01[0]) * 16.0f, (f1 - b01[1]) * 16.0f, lo, false); lo = __builtin_amdgcn_cvt_pk_fp8_f32((f2 - b23[0]) * 16.0f, (f3 - b23[1]) * 16.0f, lo, true);
                    hi4[i] = (unsigned)h; lo4[i] = (unsigned)lo; }
                *(u32x4*)(wx + lane * 16) = hi4; *(u32x4*)(wx + 1024 + lane * 16) = lo4; }
              i32x8 afr[8];
              { const unsigned char* ar = wx + (lane & 1) * 1024 + (lane >> 4) * 16;
#pragma unroll
                for (int kk = 0; kk < 8; ++kk) { const u32x4 a0 = *(const u32x4*)(ar + kk * 128), a1 = *(const u32x4*)(ar + kk * 128 + 64);
                    afr[kk] = (i32x8){(int)a0[0], (int)a0[1], (int)a0[2], (int)a0[3], (int)a1[0], (int)a1[1], (int)a1[2], (int)a1[3]}; } }
              u32x4 rawA[8], rawB[8], bfx[8];
              PEER_BLOAD(rawA, 0)
#pragma unroll 1
              for (int eg = 0; eg < 8; eg += 2) {
                  PEER_BLOAD(rawB, eg + 1)
                  PEER_BPERM(rawA, bfx) PEER_BPROC(bfx, eg)
                  if (eg + 2 < 8) { PEER_BLOAD(rawA, eg + 2) }
                  PEER_BPERM(rawB, bfx) PEER_BPROC(bfx, eg + 1)
              }
              { const float d0 = lcoef[lane], d1 = lcoef[64 + lane];
                const float c0 = gt0 * geluf_(d0 * (1.0f / PEER_U_SCALE)) * (1.0f / PEER_V_SCALE), c1 = gt1 * geluf_(d1 * (1.0f / PEER_U_SCALE)) * (1.0f / PEER_V_SCALE);
                lcoef[lane] = c0; lcoef[64 + lane] = c1; }
              int nidx0, nidx1; float ngt0, ngt1, nrs; u32x4 nxa, nxc;
              { const int ntok = (tok + nw < T) ? tok + nw : tok; PEER_TOKLOAD(ntok, nidx0, nidx1, ngt0, ngt1, nxa, nxc, nrs) }
              PEER_VLOAD(vlA, 0) PEER_VLOAD(vlB, 8) PEER_VLOAD(vlC, 16) SB
              float oacc[16];
#pragma unroll
              for (int i = 0; i < 16; ++i) oacc[i] = 0.f;
              SB
#pragma unroll 1
              for (int j0 = 0; j0 < 96; j0 += 32) {
                  PEER_VLOAD(vlD, j0 + 24) SB
                  PEER_VPROC(vlA, j0) SB
                  PEER_VLOAD(vlA, j0 + 32) SB
                  PEER_VPROC(vlB, j0 + 8) SB
                  PEER_VLOAD(vlB, j0 + 40) SB
                  PEER_VPROC(vlC, j0 + 16) SB
                  PEER_VLOAD(vlC, j0 + 48) SB
                  PEER_VPROC(vlD, j0 + 24) SB
              }
              PEER_VLOAD(vlD, 120) SB
              PEER_VPROC(vlA, 96) SB
              PEER_VPROC(vlB, 104) SB
              PEER_VPROC(vlC, 112) SB
              PEER_VPROC(vlD, 120) SB
              f32x4 xo[4]; float q = 0.f;
#pragma unroll
              for (int k = 0; k < 4; ++k) { const u32x4 xs = (k < 2) ? xa : xc; const int b0 = 2 * (k & 1);
                  xo[k] = (f32x4){bf2f((bf16_t)(xs[b0] & 0xffffu)), __uint_as_float(xs[b0] & 0xffff0000u), bf2f((bf16_t)(xs[b0 + 1] & 0xffffu)), __uint_as_float(xs[b0 + 1] & 0xffff0000u)} + (f32x4){oacc[4 * k], oacc[4 * k + 1], oacc[4 * k + 2], oacc[4 * k + 3]}; }
              if (dry) { u32x4* xb = (u32x4*)(WSP(bf16_t, WS_XSC) + (size_t)tok * D_ + lane * 16); xb[0] = (u32x4){pk2bf(xo[0][0], xo[0][1]), pk2bf(xo[0][2], xo[0][3]), pk2bf(xo[1][0], xo[1][1]), pk2bf(xo[1][2], xo[1][3])}; }
              else if (l < DEPTH - 1) {
                  u32x4 w0 = (u32x4){pk2bf(xo[0][0], xo[0][1]), pk2bf(xo[0][2], xo[0][3]), pk2bf(xo[1][0], xo[1][1]), pk2bf(xo[1][2], xo[1][3])}, w1 = (u32x4){pk2bf(xo[2][0], xo[2][1]), pk2bf(xo[2][2], xo[2][3]), pk2bf(xo[3][0], xo[3][1]), pk2bf(xo[3][2], xo[3][3])};
                  u32x4* xb = (u32x4*)(HB + (size_t)tok * D_ + lane * 16); xb[0] = w0; xb[1] = w1;
#pragma unroll
                  for (int i = 0; i < 4; ++i) { const float a0 = bf2f((bf16_t)(w0[i] & 0xffffu)), a1 = __uint_as_float(w0[i] & 0xffff0000u), c0 = bf2f((bf16_t)(w1[i] & 0xffffu)), c1 = __uint_as_float(w1[i] & 0xffff0000u); q += (a0 * a0 + a1 * a1) + (c0 * c0 + c1 * c1); }
                  q = wave_sum(q);
                  if (lane < 4) ((f32x4*)(SS + ((size_t)(3 * (l + 1)) * T + tok) * SSW))[lane] = (f32x4){lane == 0 ? q : 0.f, 0.f, 0.f, 0.f}; }
              else {
#pragma unroll
                  for (int k = 0; k < 4; ++k) q += (xo[k][0] * xo[k][0] + xo[k][1] * xo[k][1]) + (xo[k][2] * xo[k][2] + xo[k][3] * xo[k][3]);
                  q = wave_sum(q);
                  const float rsf = rstd_from_ss(q); const f32x4* gf = (const f32x4*)(p.in[23] + lane * 16); f32x4* wp = (f32x4*)(p.out + (size_t)tok * D_ + lane * 16);
#pragma unroll
                  for (int k = 0; k < 4; ++k) wp[k] = xo[k] * rsf * gf[k]; }
              idx0 = nidx0; idx1 = nidx1; gt0 = ngt0; gt1 = ngt1; rs = nrs; xa = nxa; xc = nxc;
          }
#undef SB
#undef PEER_TOKLOAD
#undef PEER_VLOAD
#undef PEER_VPROC
#undef PEER_BLOAD
#undef PEER_BPROC
          __syncthreads(); }
#endif
    } break;
    case 19: {
#ifdef EMU
        const int* pidx = WSP(int, WS_PIDX); const float* coef = WSP(float, WS_COEF); const unsigned char* tv = WSP(unsigned char, WS_TABV);
        for (int t = c.gtid; t < T; t += c.gsize) { float q = 0.f; bf16_t* xb = HB + (size_t)t * D_; float* xr = p.out + (size_t)t * D_;
            for (int d = 0; d < D_; ++d) { float sacc = 0.f; for (int j = 0; j < 128; ++j) sacc += coef[(size_t)t * 128 + j] * tab_get_sw(tv + (size_t)pidx[(size_t)t * 128 + j] * PEER_ROWB, d); xr[d] = bf2f(xb[d]) + sacc; }
            if (l < DEPTH - 1) { for (int d = 0; d < D_; ++d) { xb[d] = f2bf(xr[d]); const float x = bf2f(xb[d]); q += x * x; } SS[((size_t)(3 * (l + 1)) * T + t) * SSW] = q; }
            else { for (int d = 0; d < D_; ++d) q += xr[d] * xr[d]; const float rs = rstd_from_ss(q); for (int d = 0; d < D_; ++d) xr[d] = xr[d] * rs * p.in[23][d]; } }
#endif
    } break;
    }
}

DEV void run_stage(const Params& p, int stage) {
    if (stage == DEPTH * N_STAGES_PER_LAYER) return;
    run_stage_ls(p, stage / N_STAGES_PER_LAYER, stage % N_STAGES_PER_LAYER);
}
#ifndef EMU
#if N_LAUNCH_MODE == 0
__global__ void __launch_bounds__(NTHREADS) k_stage(Params p, int stage) { run_stage(p, stage); }
#endif
#if N_LAUNCH_MODE == 1
#define XB_TMO      128
#define XB_XCNT(j)  (256  + 64 * (j))
#define XB_XSUB(j)  (1280 + 64 * (j))
#define XB_XGEN(j)  (2304 + 64 * (j))
#define XB_TOP      3328
#define XB_TOPGEN   3392
#define XCD_BAR_WORDS 3456
#define XB_SPIN_CAP (1u << 18)
#define XLAS __attribute__((address_space(3)))

__device__ __forceinline__ unsigned xb_ld(unsigned* p)              { return __hip_atomic_load(p, __ATOMIC_RELAXED, __HIP_MEMORY_SCOPE_AGENT); }
__device__ __forceinline__ unsigned xb_add(unsigned* p, unsigned v) { return __hip_atomic_fetch_add(p, v, __ATOMIC_RELAXED, __HIP_MEMORY_SCOPE_AGENT); }
__device__ __forceinline__ unsigned xb_xcc_id() { return (unsigned)__builtin_amdgcn_s_getreg((3 << 11) | 20) & 0xFu; }
#define XB_SPIN(cond, bar) do { unsigned _sp = 0; while (cond) { __builtin_amdgcn_s_sleep(1); \
    if ((++_sp & 255u) == 0u) { if (xb_ld(&(bar)[XB_TMO])) break; if (_sp > XB_SPIN_CAP) { atomicAdd(&(bar)[XB_TMO], 1u); break; } } } } while (0)

struct XcdBarrier {
    unsigned* bar; unsigned x;
    volatile XLAS unsigned* st;
};

__device__ __forceinline__ XcdBarrier xcd_barrier_post(unsigned* bar, volatile XLAS unsigned* st) {
    XcdBarrier b; b.bar = bar; b.x = xb_xcc_id(); b.st = st;
    if (threadIdx.x == 0) (void)xb_add(&bar[XB_XCNT(b.x)], 1u);
    return b;
}
__device__ __forceinline__ void xcd_barrier_complete(unsigned* bar, unsigned x, unsigned& nloc, unsigned& nx) {
    const unsigned G = gridDim.x * gridDim.y * gridDim.z;
    unsigned sum, cnt, mine, sp = 0u;
    for (;;) {
        sum = 0u; cnt = 0u; mine = 0u;
#pragma unroll
        for (unsigned j = 0; j < 16; ++j) { const unsigned c = xb_ld(&bar[XB_XCNT(j)]); sum += c; cnt += (c > 0u) ? 1u : 0u; mine = (j == x) ? c : mine; }
        if (sum == G) break;
        __builtin_amdgcn_s_sleep(1);
        if ((++sp & 255u) == 0u) { if (xb_ld(&bar[XB_TMO])) break; if (sp > XB_SPIN_CAP) { atomicAdd(&bar[XB_TMO], 1u); break; } }
    }
    nloc = mine > 0u ? mine : 1u; nx = cnt > 0u ? cnt : 1u;
}

__device__ __forceinline__ void xcd_barrier(const XcdBarrier& b) {
    asm volatile("s_waitcnt vmcnt(0)" ::: "memory");
    __syncthreads();
    if (threadIdx.x == 0) {
        unsigned* bar = b.bar;
        __builtin_amdgcn_s_waitcnt(0);
        unsigned nloc = b.st[0], nx = b.st[1];
        if (nloc == 0u) { xcd_barrier_complete(bar, b.x, nloc, nx); b.st[0] = nloc; b.st[1] = nx; }
        const unsigned old = xb_add(&bar[XB_XSUB(b.x)], 1u);
        const unsigned gen = old / nloc;
        if (old + 1u == (gen + 1u) * nloc) {
            __builtin_amdgcn_fence(__ATOMIC_RELEASE, "agent");
            asm volatile("s_waitcnt vmcnt(0)" ::: "memory");
            const unsigned og = xb_add(&bar[XB_TOP], 1u);
            const unsigned tg = og / nx;
            if (og + 1u == (tg + 1u) * nx) xb_add(&bar[XB_TOPGEN], 1u);
            else XB_SPIN(xb_ld(&bar[XB_TOPGEN]) == tg, bar);
            __builtin_amdgcn_fence(__ATOMIC_ACQUIRE, "agent");
            xb_add(&bar[XB_XGEN(b.x)], 1u);
            asm volatile("s_waitcnt vmcnt(0)" ::: "memory");
        } else {
            XB_SPIN(xb_ld(&bar[XB_XGEN(b.x)]) == gen, bar);
            __builtin_amdgcn_fence(__ATOMIC_ACQUIRE, "agent");
            asm volatile("s_waitcnt vmcnt(0)" ::: "memory");
        }
    }
    __syncthreads();
}


typedef const unsigned long long __attribute__((address_space(4))) * kargp_t;
DEV void load_params(Params& q) { kargp_t kp = (kargp_t)__builtin_amdgcn_kernarg_segment_ptr(); asm volatile("" : "+s"(kp));
#pragma unroll
    for (int i = 0; i < 24; ++i) q.in[i] = (const float*)(const float __attribute__((address_space(1)))*)kp[i];
    q.out = (float*)(float __attribute__((address_space(1)))*)kp[24]; q.ws = (unsigned char*)(unsigned char __attribute__((address_space(1)))*)kp[25]; q.T = T_; q.pad = 0; }
__global__ void __launch_bounds__(NTHREADS) k_mega(Params p) {
    cg::grid_group grid = cg::this_grid();
    volatile XLAS unsigned* xst = (volatile XLAS unsigned*)(XLAS unsigned char*)(g_lds + 131072 + 64);
    if (threadIdx.x < 4) xst[threadIdx.x] = 0u;
    __syncthreads();
    const int wave_u = __builtin_amdgcn_readfirstlane(threadIdx.x >> 6);
    const XcdBarrier xbar = xcd_barrier_post((unsigned*)(p.ws + WS_CTL), xst);
    if (p.T < 0) grid.sync();
#define RS(k) if (DUPMASK & (1 << (k))) { { Params q; load_params(q); run_stage_ls(q, l, k, true, wave_u); } xcd_barrier(xbar); } { Params q; load_params(q); run_stage_ls(q, l, k, false, wave_u); } xcd_barrier(xbar);
#define RSL(k) { Params q; load_params(q); run_stage_ls(q, l, k, false, wave_u); } asm volatile("s_waitcnt vmcnt(0)" ::: "memory"); __syncthreads();
#pragma unroll 1
    for (int l = 0; l < DEPTH; ++l) { RS(0) RS(1) RS(2) RS(3) RS(4) RS(5) RS(6) RS(7) RS(8) RSL(10) RSL(11) RS(13) RS(14) RSL(16) RS(17) RS(18) }
#undef RS
#undef RSL
}
#define K_MAIN k_mega
#else
#define K_MAIN k_stage
#endif

extern "C" void kernel_launch(void* const* d_in, const int* in_sizes, int n_in, void* d_out, int out_size, void* d_ws, size_t ws_size, hipStream_t stream) {
    static int grid = 0;
    if (grid == 0) {
        if (n_in != 24 || out_size != T_ * D_ || ws_size < WS_END) { fprintf(stderr, "kernel_launch: unexpected shapes n_in %d out %d ws %zu\n", n_in, out_size, ws_size); grid = -1; return; }
        int dev = 0, cus = 0, per_cu = 0; hipGetDevice(&dev); hipDeviceGetAttribute(&cus, hipDeviceAttributeMultiprocessorCount, dev);
        if (hipFuncSetAttribute((const void*)K_MAIN, hipFuncAttributeMaxDynamicSharedMemorySize, LDS_BYTES) != hipSuccess) { fprintf(stderr, "hipFuncSetAttribute failed\n"); grid = -1; return; }
        hipOccupancyMaxActiveBlocksPerMultiprocessor(&per_cu, (const void*)K_MAIN, NTHREADS, LDS_BYTES);
        if (per_cu < 1) per_cu = 1;
        grid = cus * (per_cu > 1 ? 1 : 1);
    }
    if (grid < 0) return;
    hipMemsetAsync((char*)d_ws + WS_CTL, 0, 65536, stream);
    Params p{}; for (int i = 0; i < 24; ++i) p.in[i] = (const float*)d_in[i];
    p.out = (float*)d_out; p.ws = (unsigned char*)d_ws; p.T = T_; p.pad = 0;
#if N_LAUNCH_MODE == 1
    void* args[] = {&p};
    hipError_t e = hipLaunchCooperativeKernel((const void*)k_mega, dim3(grid), dim3(NTHREADS), args, LDS_BYTES, stream);
    if (e != hipSuccess) fprintf(stderr, "cooperative launch failed: %s (grid %d)\n", hipGetErrorString(e), grid);
#else
    for (int s = 0; s < N_STAGES; ++s) hipLaunchKernelGGL(k_stage, dim3(grid), dim3(NTHREADS), LDS_BYTES, stream, p, s);
#endif
}
#endif
```
